# Optimizing an MI355X kernel written in HIP

```python
import functools
import jax, jax.numpy as jnp
from jax import lax
import numpy as np

D_MODEL = 2048
BATCH = 8
SEQ = 2048
DEPTH = 4

D_FF = 5632
NORM_EPS = 1e-5
BLOCK = 128
NEG_INF = -1e30
MIXER_KINDS = ("gmlp", "swa", "fox")
N_MIXERS = 3
GMLP_WIDTH = D_MODEL
GMLP_CHUNK = 128
GMLP_GROUPS = 16
GMLP_GROUP_WIDTH = GMLP_WIDTH // GMLP_GROUPS
SWA_HEAD_DIM = 64
SWA_Q_HEADS = D_MODEL // SWA_HEAD_DIM
SWA_KV_HEADS = SWA_Q_HEADS // 8
SWA_WIDTH = SWA_Q_HEADS * SWA_HEAD_DIM
SWA_KV_WIDTH = SWA_KV_HEADS * SWA_HEAD_DIM
SWA_WINDOW = 128
ROPE_THETA = 500000.0
ROPE_DIM = SWA_HEAD_DIM // 4
FOX_HEAD_DIM = 128
FOX_HEADS = D_MODEL // FOX_HEAD_DIM
FOX_WIDTH = FOX_HEADS * FOX_HEAD_DIM

kernel_name = "hybrid_gmlp_swa_fox_macaron"


def rms_norm(x, g):
    x32 = x.astype(jnp.float32)
    y = x32 * lax.rsqrt(jnp.mean(x32 * x32, axis=-1, keepdims=True) + NORM_EPS)
    return (y * g.astype(jnp.float32)).astype(x.dtype)


def swiglu_ffn(h, wi, wo):
    gate, up = jnp.split(h @ wi, 2, axis=-1)
    return (jax.nn.silu(gate) * up) @ wo


def partial_rotary(x, pos):
    half = ROPE_DIM // 2
    inv_freq = ROPE_THETA ** (-(jnp.arange(half, dtype=jnp.float32) * 2.0 / ROPE_DIM))
    ang = pos.astype(jnp.float32)[:, None] * inv_freq[None, :]
    cos = jnp.cos(ang)[None, :, None, :]
    sin = jnp.sin(ang)[None, :, None, :]
    xr = x[..., :ROPE_DIM].astype(jnp.float32)
    x1, x2 = xr[..., :half], xr[..., half:]
    rot = jnp.concatenate([x1 * cos - x2 * sin, x2 * cos + x1 * sin], axis=-1).astype(x.dtype)
    return jnp.concatenate([rot, x[..., ROPE_DIM:]], axis=-1)


def gmlp_mixer(h, w_in, v_gain, w_s, b_s, w_out):
    B, S, _ = h.shape
    z = jax.nn.gelu(h @ w_in, approximate=False)
    u, v = jnp.split(z, 2, axis=-1)
    v = rms_norm(v, v_gain)
    nc = S // GMLP_CHUNK
    v = v.reshape(B, nc, GMLP_CHUNK, GMLP_GROUPS, GMLP_GROUP_WIDTH)
    causal = jnp.tril(jnp.ones((GMLP_CHUNK, GMLP_CHUNK), dtype=bool))
    ws = jnp.where(causal[None], w_s, jnp.zeros_like(w_s))
    mixed = jnp.einsum('gts,bcsgw->bctgw', ws, v) + b_s.T[:, :, None]
    y = u * mixed.reshape(B, S, GMLP_WIDTH)
    return y @ w_out


def swa_mixer(h, w_in, sinks, w_out):
    B, S, _ = h.shape
    nb = S // BLOCK
    G = SWA_Q_HEADS // SWA_KV_HEADS
    q, k, v = jnp.split(h @ w_in, [SWA_WIDTH, SWA_WIDTH + SWA_KV_WIDTH], axis=-1)
    q = q.reshape(B, S, SWA_Q_HEADS, SWA_HEAD_DIM)
    k = k.reshape(B, S, SWA_KV_HEADS, SWA_HEAD_DIM)
    v = v.reshape(B, S, SWA_KV_HEADS, SWA_HEAD_DIM)
    pos = jnp.arange(S)
    q = partial_rotary(q, pos)
    k = partial_rotary(k, pos)
    qb = q.reshape(B, nb, BLOCK, SWA_KV_HEADS, G, SWA_HEAD_DIM).astype(jnp.float32)

    def band(t):
        tb = t.reshape(B, nb, BLOCK, SWA_KV_HEADS, SWA_HEAD_DIM)
        prev = jnp.concatenate([jnp.zeros_like(tb[:, :1]), tb[:, :-1]], axis=1)
        return jnp.concatenate([prev, tb], axis=2).astype(jnp.float32)

    kb, vb = band(k), band(v)
    s = jnp.einsum('bnqkgd,bnskd->bnkgqs', qb, kb) * (SWA_HEAD_DIM ** -0.5)
    start = jnp.arange(nb)[:, None, None] * BLOCK
    qpos = start + jnp.arange(BLOCK)[None, :, None]
    kpos = start - BLOCK + jnp.arange(2 * BLOCK)[None, None, :]
    valid = (kpos <= qpos) & (qpos - kpos < SWA_WINDOW) & (kpos >= 0)
    s = jnp.where(valid[None, :, None, None], s, NEG_INF)
    sink = sinks.astype(jnp.float32).reshape(1, 1, SWA_KV_HEADS, G, 1, 1)
    m = jnp.maximum(jnp.max(s, axis=-1, keepdims=True), sink)
    p = jnp.exp(s - m)
    denom = jnp.sum(p, axis=-1, keepdims=True) + jnp.exp(sink - m)
    o = jnp.einsum('bnkgqs,bnskd->bnqkgd', p / denom, vb)
    o = o.reshape(B, S, SWA_WIDTH).astype(h.dtype)
    return o @ w_out


def fox_mixer(h, w_in, b_f, w_out):
    B, S, _ = h.shape
    nb = S // BLOCK
    q, k, v, fl = jnp.split(h @ w_in, [FOX_WIDTH, 2 * FOX_WIDTH, 3 * FOX_WIDTH], axis=-1)
    q = q.reshape(B, S, FOX_HEADS, FOX_HEAD_DIM)
    kf = k.reshape(B, S, FOX_HEADS, FOX_HEAD_DIM).astype(jnp.float32)
    vf = v.reshape(B, S, FOX_HEADS, FOX_HEAD_DIM).astype(jnp.float32)
    log_f = jax.nn.log_sigmoid(fl.astype(jnp.float32) + b_f.astype(jnp.float32))
    dec = jnp.cumsum(log_f, axis=1).transpose(0, 2, 1)
    kpos = jnp.arange(S)
    scale = FOX_HEAD_DIM ** -0.5

    def attend_block(i):
        start = i * BLOCK
        qb = lax.dynamic_slice_in_dim(q, start, BLOCK, axis=1).astype(jnp.float32)
        db = lax.dynamic_slice_in_dim(dec, start, BLOCK, axis=2)
        s = jnp.einsum('bqhd,bshd->bhqs', qb, kf) * scale + db[..., None] - dec[:, :, None, :]
        qpos = start + jnp.arange(BLOCK)
        s = jnp.where(kpos[None, :] <= qpos[:, None], s, NEG_INF)
        p = jax.nn.softmax(s, axis=-1)
        return jnp.einsum('bhqs,bshd->bqhd', p, vf)

    o = lax.map(attend_block, jnp.arange(nb))
    o = o.transpose(1, 0, 2, 3, 4).reshape(B, S, FOX_WIDTH).astype(h.dtype)
    return o @ w_out


def setup_inputs(seed: int = 0) -> dict:
    key = jax.random.key(seed)
    keys = iter(jax.random.split(key, 16 * DEPTH + 4))

    def nrm(shape, scale):
        return jax.random.normal(next(keys), shape, jnp.float32) * scale

    def gain(n):
        return 1.0 + 0.1 * nrm((n,), 1.0)

    inp = {"x": nrm((BATCH, SEQ, D_MODEL), 1.0)}
    for i in range(DEPTH):
        kind = MIXER_KINDS[i % N_MIXERS]
        p = f"l{i}_"
        inp[p + "ffn1_norm"] = gain(D_MODEL)
        inp[p + "ffn1_wi"] = nrm((D_MODEL, 2 * D_FF), D_MODEL ** -0.5)
        inp[p + "ffn1_wo"] = nrm((D_FF, D_MODEL), D_FF ** -0.5)
        inp[p + "mix_norm"] = gain(D_MODEL)
        if kind == "gmlp":
            inp[p + "mix_win"] = nrm((D_MODEL, 2 * GMLP_WIDTH), D_MODEL ** -0.5)
            inp[p + "gmlp_vnorm"] = gain(GMLP_WIDTH)
            inp[p + "gmlp_ws"] = nrm((GMLP_GROUPS, GMLP_CHUNK, GMLP_CHUNK), GMLP_CHUNK ** -0.5)
            inp[p + "gmlp_bs"] = 1.0 + 0.1 * nrm((GMLP_GROUPS, GMLP_CHUNK), 1.0)
            mix_width = GMLP_WIDTH
        elif kind == "swa":
            inp[p + "mix_win"] = nrm((D_MODEL, SWA_WIDTH + 2 * SWA_KV_WIDTH), D_MODEL ** -0.5)
            inp[p + "swa_sinks"] = nrm((SWA_Q_HEADS,), 0.5)
            mix_width = SWA_WIDTH
        else:
            inp[p + "mix_win"] = nrm((D_MODEL, 3 * FOX_WIDTH + FOX_HEADS), D_MODEL ** -0.5)
            inp[p + "fox_bf"] = 1.0 + 0.5 * nrm((FOX_HEADS,), 1.0)
            mix_width = FOX_WIDTH
        inp[p + "mix_wout"] = nrm((mix_width, D_MODEL), mix_width ** -0.5)
        inp[p + "ffn2_norm"] = gain(D_MODEL)
        inp[p + "ffn2_wi"] = nrm((D_MODEL, 2 * D_FF), D_MODEL ** -0.5)
        inp[p + "ffn2_wo"] = nrm((D_FF, D_MODEL), D_FF ** -0.5)
    inp["final_norm"] = gain(D_MODEL)
    return inp


def reference(x,
              l0_ffn1_norm, l0_ffn1_wi, l0_ffn1_wo, l0_mix_norm, l0_mix_win,
              l0_gmlp_vnorm, l0_gmlp_ws, l0_gmlp_bs, l0_mix_wout,
              l0_ffn2_norm, l0_ffn2_wi, l0_ffn2_wo,
              l1_ffn1_norm, l1_ffn1_wi, l1_ffn1_wo, l1_mix_norm, l1_mix_win,
              l1_swa_sinks, l1_mix_wout,
              l1_ffn2_norm, l1_ffn2_wi, l1_ffn2_wo,
              l2_ffn1_norm, l2_ffn1_wi, l2_ffn1_wo, l2_mix_norm, l2_mix_win,
              l2_fox_bf, l2_mix_wout,
              l2_ffn2_norm, l2_ffn2_wi, l2_ffn2_wo,
              l3_ffn1_norm, l3_ffn1_wi, l3_ffn1_wo, l3_mix_norm, l3_mix_win,
              l3_gmlp_vnorm, l3_gmlp_ws, l3_gmlp_bs, l3_mix_wout,
              l3_ffn2_norm, l3_ffn2_wi, l3_ffn2_wo,
              final_norm):
    ffn_params = [
        (l0_ffn1_norm, l0_ffn1_wi, l0_ffn1_wo, l0_mix_norm, l0_ffn2_norm, l0_ffn2_wi, l0_ffn2_wo),
        (l1_ffn1_norm, l1_ffn1_wi, l1_ffn1_wo, l1_mix_norm, l1_ffn2_norm, l1_ffn2_wi, l1_ffn2_wo),
        (l2_ffn1_norm, l2_ffn1_wi, l2_ffn1_wo, l2_mix_norm, l2_ffn2_norm, l2_ffn2_wi, l2_ffn2_wo),
        (l3_ffn1_norm, l3_ffn1_wi, l3_ffn1_wo, l3_mix_norm, l3_ffn2_norm, l3_ffn2_wi, l3_ffn2_wo),
    ]
    mixers = [
        functools.partial(gmlp_mixer, w_in=l0_mix_win, v_gain=l0_gmlp_vnorm, w_s=l0_gmlp_ws,
                          b_s=l0_gmlp_bs, w_out=l0_mix_wout),
        functools.partial(swa_mixer, w_in=l1_mix_win, sinks=l1_swa_sinks, w_out=l1_mix_wout),
        functools.partial(fox_mixer, w_in=l2_mix_win, b_f=l2_fox_bf, w_out=l2_mix_wout),
        functools.partial(gmlp_mixer, w_in=l3_mix_win, v_gain=l3_gmlp_vnorm, w_s=l3_gmlp_ws,
                          b_s=l3_gmlp_bs, w_out=l3_mix_wout),
    ]
    h = x
    for i in range(DEPTH):
        n1, wi1, wo1, nm, n2, wi2, wo2 = ffn_params[i]
        h = h + 0.5 * swiglu_ffn(rms_norm(h, n1), wi1, wo1)
        h = h + mixers[i](rms_norm(h, nm))
        h = h + 0.5 * swiglu_ffn(rms_norm(h, n2), wi2, wo2)
    return rms_norm(h, final_norm)
```

```cpp
#include <hip/hip_runtime.h>
#include <cstdio>
#include <cstdint>
namespace pg8 {
#define PG8_LAS __attribute__((address_space(3)))
typedef unsigned short bf16_t;
typedef short bf16x8 __attribute__((ext_vector_type(8)));
typedef float f32x4 __attribute__((ext_vector_type(4)));
typedef unsigned u32x4 __attribute__((ext_vector_type(4)));
constexpr int BM = 256, BK = 64, HALF = 128, HTB = HALF * BK * 2  , STAGE_BYTES = 8 * HTB, NXCD = 8, WGM = 8;

__host__ __device__ __forceinline__ int lds_byte(int r, int c) { const int st = (r >> 4) * 2 + (c >> 5), rr = r & 15, cc = c & 31, ob = rr * 64 + cc * 2; return st * 1024 + (ob ^ (((ob >> 9) & 1) << 5)); }
__host__ __device__ __forceinline__ void stage_rc(int b, int& R, int& C) { const int st = b / 1024, sb = b % 1024, swz = sb ^ (((sb >> 9) & 1) << 5); R = (st >> 1) * 16 + swz / 64; C = (st & 1) * 32 + (swz % 64) / 2; }
__host__ __device__ __forceinline__ int perm32(int rho) { const int n = rho >> 4, i = rho & 15; return 8 * (i >> 2) + 4 * n + (i & 3); }

struct Unit { int pm, pn; };
struct Gemm { const bf16_t* A; const bf16_t* Bt; int M, N, K; };

struct StaticOrder {
    int nM, nN, nwg, G, c;
    __host__ __device__ void init(int M, int N, int G_, int c_) { nM = M / BM; nN = N / BM; nwg = nM * nN; G = G_; c = c_; }
    __host__ __device__ bool next(int i, Unit& u) const {
        const long L = (long)i * G + c; if (L >= nwg) return false;
        int wgid = (int)L; { const int q = nwg / NXCD, r = nwg % NXCD, xcd = wgid % NXCD, off = wgid / NXCD; wgid = (xcd < r ? xcd * (q + 1) : r * (q + 1) + (xcd - r) * q) + off; }
        const int nig = WGM * nN, gid = wgid / nig, fm = gid * WGM, gsz = (nM - fm) < WGM ? (nM - fm) : WGM;
        u.pm = fm + ((wgid % nig) % gsz); u.pn = (wgid % nig) / gsz; return true;
    }
    __device__ __forceinline__ void a_ready(const Unit&) const {}
    __device__ __forceinline__ void done(const Unit&) const {}
};

__device__ __forceinline__ unsigned cvt_pk_bf16(float lo, float hi) { unsigned r; asm volatile("v_cvt_pk_bf16_f32 %0, %1, %2" : "=v"(r) : "v"(lo), "v"(hi)); return r; }
typedef float f32x2 __attribute__((ext_vector_type(2)));
__device__ __forceinline__ f32x2 gelu_pk(f32x2 v) {
    const f32x2 av = __builtin_elementwise_abs(v), d = av * 0.2316418882f + 1.0f;
    f32x2 t; t.x = __builtin_amdgcn_rcpf(d.x); t.y = __builtin_amdgcn_rcpf(d.y);
    f32x2 q = t * 0.5307027145f + (-0.7265760135f); q = q * t + 0.7107068705f; q = q * t + (-0.142248368f); q = q * t + 0.127414796f; q = q * t;
    const f32x2 s = (v * v) * (-0.72134752044f);
    f32x2 e; e.x = __builtin_amdgcn_exp2f(s.x); e.y = __builtin_amdgcn_exp2f(s.y);
    const f32x2 m = v * (q * e), r = v - m;
    f32x2 o; o.x = v.x < 0.f ? m.x : r.x; o.y = v.y < 0.f ? m.y : r.y; return o;
}

template <int ACT  > struct EpiBf16 {
    static constexpr bool PERM = true, AFTER_DRAIN = false; static_assert(ACT == 0 || ACT == 1, "EpiBf16: ACT is 0 (none) or 1 (gelu_pk)");
    bf16_t* O; int ldc; const float* bias; int split_cols; size_t split_stride; float scale0;
    __device__ __forceinline__ void operator()(const f32x4 (&acc)[2][2][4][2], const Unit& u, int wr, int wc, int fr, int fq) const {
        const int row0 = u.pm * BM + wr * 64 + fr; int colt = u.pn * BM; bf16_t* base = O;
        float sc = 1.f; if (split_cols) { const int t = colt / split_cols; base += (size_t)t * split_stride; colt -= t * split_cols; if (t == 0) sc = scale0; }
        const int col0 = colt + wc * 32 + 8 * fq, bcol0 = u.pn * BM + wc * 32 + 8 * fq;
        f32x4 bv[2][2];
#pragma unroll
        for (int bj = 0; bj < 2; ++bj)
#pragma unroll
            for (int n = 0; n < 2; ++n) bv[bj][n] = bias ? *(const f32x4*)(bias + bcol0 + bj * HALF + 4 * n) : (f32x4){0.f, 0.f, 0.f, 0.f};
#pragma unroll
        for (int ai = 0; ai < 2; ++ai)
#pragma unroll
            for (int m = 0; m < 4; ++m) { bf16_t* rowp = base + (size_t)(row0 + ai * HALF + m * 16) * ldc + col0;
#pragma unroll
                for (int bj = 0; bj < 2; ++bj) { f32x4 v0 = acc[ai][bj][m][0] + bv[bj][0], v1 = acc[ai][bj][m][1] + bv[bj][1];
                    if (ACT == 1) { f32x2 a = gelu_pk((f32x2){v0[0], v0[1]}), b = gelu_pk((f32x2){v0[2], v0[3]}), c = gelu_pk((f32x2){v1[0], v1[1]}), d = gelu_pk((f32x2){v1[2], v1[3]});
                        v0 = (f32x4){a.x, a.y, b.x, b.y}; v1 = (f32x4){c.x, c.y, d.x, d.y}; }
                    v0 = v0 * sc; v1 = v1 * sc; u32x4 w; w.x = cvt_pk_bf16(v0[0], v0[1]); w.y = cvt_pk_bf16(v0[2], v0[3]); w.z = cvt_pk_bf16(v1[0], v1[1]); w.w = cvt_pk_bf16(v1[2], v1[3]);
                    *(u32x4*)(rowp + bj * HALF) = w; } }
    }
};
template <class Epi, class Sched, bool ALIGN_EPI = false, bool SP2 = false>
__device__ __forceinline__ void gemm_phase(PG8_LAS unsigned char* lds, const Gemm g, const Sched& S, const Epi& E) {
    int tid_l = threadIdx.x; asm volatile("" : "+v"(tid_l));
    const int tid = tid_l, wid = __builtin_amdgcn_readfirstlane(tid >> 6), lane = tid & 63, wr = wid >> 2, wc = wid & 3, fr = lane & 15, fq = lane >> 4;
    const int K = g.K, nt = K / BK;
    unsigned voffA[2], voffB[2];
#pragma unroll
    for (int i = 0; i < 2; ++i) { int R, C; stage_rc(tid * 16 + i * 8192, R, C); const int Rb = Epi::PERM ? ((R & ~31) + perm32(R & 31)) : R;
        voffA[i] = (unsigned)(R * K + C) * 2u; voffB[i] = (unsigned)(Rb * K + C) * 2u; }
    const size_t kstep = (size_t)(BK * 2);
    const size_t hstep = (size_t)HALF * K * 2;
    const size_t tstep = 2 * hstep;
    const unsigned ldsw = (unsigned)wid * 1024u;
    const int aoff = lds_byte(wr * 64 + fr, fq * 8), boff = lds_byte(wc * 32 + fr, fq * 8);
#define PG8_SA(b, h) (((b) * 2 + (h)) * HTB)
#define PG8_SB(b, h) ((4 + (b) * 2 + (h)) * HTB)
#define PG8_STAGE(bufoff, gbase, voff) do { _Pragma("unroll") for (int _i = 0; _i < 2; ++_i) \
        __builtin_amdgcn_global_load_lds((const unsigned*)((const char*)(gbase) + (voff)[_i]), (PG8_LAS unsigned*)(lds + (bufoff) + ldsw + _i * 8192), 16, 0, 0); } while (0)
#define PG8_LDA(dst, b, h) do { _Pragma("unroll") for (int m = 0; m < 4; ++m) _Pragma("unroll") for (int k = 0; k < 2; ++k) dst[m][k] = *(const PG8_LAS bf16x8*)(lds + PG8_SA(b, h) + aoff + m * 2048 + k * 1024); } while (0)
#define PG8_LDB(dst, b, h) do { _Pragma("unroll") for (int n = 0; n < 2; ++n) _Pragma("unroll") for (int k = 0; k < 2; ++k) dst[n][k] = *(const PG8_LAS bf16x8*)(lds + PG8_SB(b, h) + boff + n * 2048 + k * 1024); } while (0)
#define PG8_MMA(ai, bj, At, Bt) do { __builtin_amdgcn_s_setprio(1); _Pragma("unroll") for (int m = 0; m < 4; ++m) _Pragma("unroll") for (int n = 0; n < 2; ++n) _Pragma("unroll") for (int k = 0; k < 2; ++k) \
        acc[ai][bj][m][n] = __builtin_amdgcn_mfma_f32_16x16x32_bf16(Bt[n][k], At[m][k], acc[ai][bj][m][n], 0, 0, 0); __builtin_amdgcn_s_setprio(0); } while (0)
#define PG8_WAIT_V(n) asm volatile("s_waitcnt vmcnt(" #n ")" ::: "memory")
#define PG8_WAIT_L(n) asm volatile("s_waitcnt lgkmcnt(" #n ")" ::: "memory")
#define PG8_BAR __builtin_amdgcn_s_barrier()
#define PG8_SCHED __builtin_amdgcn_sched_barrier(0)
    Unit cur, nxt; int ui = 0;
    if (!S.next(0, cur)) return;
    f32x4 acc[2][2][4][2];
#pragma unroll
    for (int a = 0; a < 2; ++a)
#pragma unroll
        for (int b = 0; b < 2; ++b)
#pragma unroll
            for (int m = 0; m < 4; ++m)
#pragma unroll
                for (int n = 0; n < 2; ++n) acc[a][b][m][n] = (f32x4){0.f, 0.f, 0.f, 0.f};
    bf16x8 At[4][2], B0[2][2], B1[2][2];
    const char* cA = (const char*)g.A + (size_t)cur.pm * tstep; const char* cB = (const char*)g.Bt + (size_t)cur.pn * tstep;
    S.a_ready(cur);
    if constexpr (SP2) {
        PG8_STAGE(PG8_SB(0, 0), cB, voffB); PG8_STAGE(PG8_SB(0, 1), cB + hstep, voffB); PG8_STAGE(PG8_SA(0, 0), cA, voffA); PG8_STAGE(PG8_SA(0, 1), cA + hstep, voffA);
        if (wr == 1) PG8_BAR;
        PG8_WAIT_V(2); PG8_BAR;
        PG8_STAGE(PG8_SB(1, 0), cB + kstep, voffB); PG8_STAGE(PG8_SA(1, 0), cA + kstep, voffA); PG8_STAGE(PG8_SB(1, 1), cB + hstep + kstep, voffB);
        PG8_WAIT_V(6); PG8_BAR;
    } else {
        PG8_STAGE(PG8_SB(0, 0), cB, voffB); PG8_STAGE(PG8_SA(0, 0), cA, voffA); PG8_STAGE(PG8_SB(0, 1), cB + hstep, voffB); PG8_STAGE(PG8_SA(0, 1), cA + hstep, voffA);
        if (wr == 1) PG8_BAR;
        PG8_WAIT_V(4); PG8_BAR;
        PG8_STAGE(PG8_SB(1, 0), cB + kstep, voffB); PG8_STAGE(PG8_SA(1, 0), cA + kstep, voffA); PG8_STAGE(PG8_SB(1, 1), cB + hstep + kstep, voffB);
        PG8_WAIT_V(6); PG8_BAR;
    }
    for (;;) {
        const bool has_next = S.next(ui + 1, nxt);
        const char* nA = has_next ? (const char*)g.A + (size_t)nxt.pm * tstep : cA; const char* nB = has_next ? (const char*)g.Bt + (size_t)nxt.pn * tstep : cB;
        for (int t = 0; t < nt; t += 2) {
            const bool last = (t == nt - 2);
            const char* a1 = cA + (size_t)(t + 1) * kstep;
            const char* a2 = last ? nA : cA + (size_t)(t + 2) * kstep; const char* b2 = last ? nB : cB + (size_t)(t + 2) * kstep;
            const char* a3 = a2 + kstep; const char* b3 = b2 + kstep;
            if (last && has_next) S.a_ready(nxt);
            if constexpr (SP2) {
            PG8_LDB(B0, 0, 0); PG8_LDB(B1, 0, 1); PG8_SCHED; PG8_LDA(At, 0, 0); PG8_STAGE(PG8_SA(1, 1), a1 + hstep, voffA);
            PG8_WAIT_V(8); PG8_WAIT_L(0); PG8_BAR; PG8_MMA(0, 0, At, B0); PG8_MMA(0, 1, At, B1); PG8_BAR; PG8_SCHED;
            PG8_LDA(At, 0, 1); PG8_STAGE(PG8_SB(0, 0), b2, voffB); PG8_STAGE(PG8_SB(0, 1), b2 + hstep, voffB); PG8_STAGE(PG8_SA(0, 0), a2, voffA);
            PG8_WAIT_V(8); PG8_WAIT_L(0); PG8_BAR; PG8_MMA(1, 0, At, B0); PG8_MMA(1, 1, At, B1); PG8_BAR; PG8_SCHED;
            PG8_LDB(B0, 1, 0); PG8_LDB(B1, 1, 1); PG8_SCHED; PG8_LDA(At, 1, 0); PG8_STAGE(PG8_SA(0, 1), a2 + hstep, voffA);
            PG8_WAIT_V(8); PG8_WAIT_L(0); PG8_BAR; PG8_MMA(0, 0, At, B0); PG8_MMA(0, 1, At, B1); PG8_BAR; PG8_SCHED;
            PG8_LDA(At, 1, 1); PG8_STAGE(PG8_SB(1, 0), b3, voffB); PG8_STAGE(PG8_SB(1, 1), b3 + hstep, voffB); PG8_STAGE(PG8_SA(1, 0), a3, voffA);
            PG8_WAIT_V(8); PG8_WAIT_L(0); PG8_BAR; PG8_MMA(1, 0, At, B0); PG8_MMA(1, 1, At, B1); PG8_BAR; PG8_SCHED;
            } else {
            PG8_LDB(B0, 0, 0); PG8_SCHED; PG8_LDA(At, 0, 0); PG8_STAGE(PG8_SA(1, 1), a1 + hstep, voffA);
            PG8_WAIT_L(8); PG8_BAR; PG8_WAIT_L(0); PG8_MMA(0, 0, At, B0); PG8_BAR; PG8_SCHED;
            PG8_LDB(B1, 0, 1); PG8_STAGE(PG8_SB(0, 0), b2, voffB);
            PG8_BAR; PG8_WAIT_L(0); PG8_MMA(0, 1, At, B1); PG8_BAR;
            PG8_LDA(At, 0, 1); PG8_STAGE(PG8_SA(0, 0), a2, voffA);
            PG8_BAR; PG8_WAIT_L(0); PG8_MMA(1, 0, At, B0); PG8_BAR; PG8_SCHED;
            PG8_STAGE(PG8_SB(0, 1), b2 + hstep, voffB);
            PG8_WAIT_V(6); PG8_BAR; PG8_MMA(1, 1, At, B1); PG8_BAR;
            PG8_LDB(B0, 1, 0); PG8_SCHED; PG8_LDA(At, 1, 0); PG8_STAGE(PG8_SA(0, 1), a2 + hstep, voffA);
            PG8_WAIT_L(8); PG8_BAR; PG8_WAIT_L(0); PG8_MMA(0, 0, At, B0); PG8_BAR; PG8_SCHED;
            PG8_LDB(B1, 1, 1); PG8_STAGE(PG8_SB(1, 0), b3, voffB);
            PG8_BAR; PG8_WAIT_L(0); PG8_MMA(0, 1, At, B1); PG8_BAR;
            PG8_LDA(At, 1, 1); PG8_STAGE(PG8_SA(1, 0), a3, voffA);
            PG8_BAR; PG8_WAIT_L(0); PG8_MMA(1, 0, At, B0); PG8_BAR; PG8_SCHED;
            PG8_STAGE(PG8_SB(1, 1), b3 + hstep, voffB);
            PG8_WAIT_V(6); PG8_BAR; PG8_MMA(1, 1, At, B1); PG8_BAR;
            }
        }
        if constexpr (ALIGN_EPI) { if (wr == 0) PG8_BAR; }
        if constexpr (!Epi::AFTER_DRAIN) { E(acc, cur, wr, wc, fr, fq); S.done(cur); }
        if (!has_next) break;
#pragma unroll
        for (int a = 0; a < 2; ++a)
#pragma unroll
            for (int b = 0; b < 2; ++b)
#pragma unroll
                for (int m = 0; m < 4; ++m)
#pragma unroll
                    for (int n = 0; n < 2; ++n) acc[a][b][m][n] = (f32x4){0.f, 0.f, 0.f, 0.f};
        cur = nxt; cA = nA; cB = nB; ++ui;
        if constexpr (ALIGN_EPI) { if (wr == 1) PG8_BAR; }
    }
    PG8_WAIT_V(0);
    if constexpr (!ALIGN_EPI) { if (wr == 0) PG8_BAR; }
    PG8_BAR;
    if constexpr (Epi::AFTER_DRAIN) { E.fused(acc, cur, wr, wc, fr, fq, lds, wid, lane); S.done(cur); }
#undef PG8_SA
#undef PG8_SB
#undef PG8_STAGE
#undef PG8_LDA
#undef PG8_LDB
#undef PG8_MMA
#undef PG8_WAIT_V
#undef PG8_WAIT_L
#undef PG8_BAR
#undef PG8_SCHED
}
}
namespace pg8 {
struct EpiResid {
    static constexpr bool PERM = false, AFTER_DRAIN = false;
    float* C; int ldc; float coef;
    __device__ __forceinline__ void operator()(const f32x4 (&acc)[2][2][4][2], const Unit& u, int wr, int wc, int fr, int fq) const {
        const int row0 = u.pm * BM + wr * 64 + fr, col0 = u.pn * BM + wc * 32 + 4 * fq;
#pragma unroll
        for (int ai = 0; ai < 2; ++ai)
#pragma unroll
            for (int m = 0; m < 4; ++m) { float* rowp = C + (size_t)(row0 + ai * HALF + m * 16) * ldc + col0;
#pragma unroll
                for (int bj = 0; bj < 2; ++bj)
#pragma unroll
                    for (int n = 0; n < 2; ++n) { f32x4* p = (f32x4*)(rowp + bj * HALF + n * 16); const f32x4 o = *p; *p = o + acc[ai][bj][m][n] * coef; }
                asm volatile("" ::: "memory"); }
    }
};
}

#ifndef MK_N_LAUNCHES
#define MK_N_LAUNCHES 0
#endif

constexpr int NWAVES = 8;
constexpr int BATCH = 8, SEQ = 2048, D = 2048, FF = 5632, M = BATCH * SEQ;
constexpr float EPS = 1e-5f;
constexpr int GM_N = 4096, SWA_N = 2560, FOX_N = 6144, FOX_LD = 6160;
constexpr size_t MiB = 1u << 20;
constexpr size_t WS_CTL = 0, CTL_ZERO_BYTES = 1 * MiB;
constexpr size_t WS_W = 1 * MiB;
constexpr size_t WS_FFN_STRIDE = 66 * MiB, WS_WO_OFF = 44 * MiB;
constexpr size_t WS_MW = WS_W + 8 * WS_FFN_STRIDE;
constexpr size_t WS_XN = WS_MW + 98 * MiB;
constexpr size_t WS_BIG = WS_XN + 64 * MiB;
constexpr size_t WS_HID = WS_BIG + 352 * MiB;
constexpr size_t WS_SMALL = WS_HID + 176 * MiB;
constexpr size_t WS_END = WS_SMALL + 3 * MiB;
__host__ __device__ constexpr size_t mw_win_off(int L) { return (L == 0 ? 0 : L == 1 ? 24 : L == 2 ? 42 : 74) * MiB; }
__host__ __device__ constexpr size_t mw_wout_off(int L) { return (L == 0 ? 16 : L == 1 ? 34 : L == 2 ? 66 : 90) * MiB; }
constexpr int CW_BAR = 4096;
constexpr int RING_OFF = 0, RING_BYTES = 131072;
constexpr int LDSCTL_OFF = RING_BYTES, MISC_OFF = LDSCTL_OFF + 320;
constexpr int LDS_BYTES = 147456;

#define GAS __attribute__((address_space(1)))
#define LAS __attribute__((address_space(3)))
typedef unsigned short bf16;
typedef unsigned v4u __attribute__((ext_vector_type(4)));
typedef float f32x4 __attribute__((ext_vector_type(4)));
typedef short bf16x8 __attribute__((ext_vector_type(8)));
typedef GAS unsigned gu32;
typedef GAS unsigned long long gu64;
#define RLX_AGENT __ATOMIC_RELAXED, __HIP_MEMORY_SCOPE_AGENT
#define LDS_WAIT() asm volatile("s_waitcnt lgkmcnt(0)" ::: "memory")
#define VM_WAIT() asm volatile("s_waitcnt vmcnt(0)" ::: "memory")
__device__ __forceinline__ unsigned long long rt() { return __builtin_amdgcn_s_memrealtime(); }
__device__ __forceinline__ unsigned f2bf(float f) { unsigned u = __builtin_bit_cast(unsigned, f); return (u + 0x7fffu + ((u >> 16) & 1u)) >> 16; }
__device__ __forceinline__ unsigned pk2(float lo, float hi) { return f2bf(lo) | (f2bf(hi) << 16); }

#define XB_TMO      128
#define XB_XCNT(j)  (256  + 64 * (j))
#define XB_XSUB(j)  (1280 + 64 * (j))
#define XB_XGEN(j)  (2304 + 64 * (j))
#define XB_TOP      3328
#define XB_TOPGEN   3392
#define XCD_BAR_WORDS 3456
#define XB_SPIN_CAP (1u << 18)

__device__ __forceinline__ unsigned xb_ld(unsigned* p)              { return __hip_atomic_load(p, __ATOMIC_RELAXED, __HIP_MEMORY_SCOPE_AGENT); }
__device__ __forceinline__ unsigned xb_add(unsigned* p, unsigned v) { return __hip_atomic_fetch_add(p, v, __ATOMIC_RELAXED, __HIP_MEMORY_SCOPE_AGENT); }
__device__ __forceinline__ unsigned xb_xcc_id() { return (unsigned)__builtin_amdgcn_s_getreg((3 << 11) | 20) & 0xFu; }
#define XB_SPIN(cond, bar) do { unsigned _sp = 0; while (cond) { __builtin_amdgcn_s_sleep(1); \
    if ((++_sp & 255u) == 0u) { if (xb_ld(&(bar)[XB_TMO])) break; if (_sp > XB_SPIN_CAP) { atomicAdd(&(bar)[XB_TMO], 1u); break; } } } } while (0)

struct XcdBarrier {
    unsigned* bar; unsigned x;
    volatile LAS unsigned* st;
};

__device__ __forceinline__ XcdBarrier xcd_barrier_post(unsigned* bar, volatile LAS unsigned* st) {
    XcdBarrier b; b.bar = bar; b.x = xb_xcc_id(); b.st = st;
    if (threadIdx.x == 0) (void)xb_add(&bar[XB_XCNT(b.x)], 1u);
    return b;
}
__device__ __forceinline__ void xcd_barrier_complete(unsigned* bar, unsigned x, unsigned& nloc, unsigned& nx) {
    const unsigned G = gridDim.x * gridDim.y * gridDim.z;
    unsigned sum, cnt, mine, sp = 0u;
    for (;;) {
        sum = 0u; cnt = 0u; mine = 0u;
#pragma unroll
        for (unsigned j = 0; j < 16; ++j) { const unsigned c = xb_ld(&bar[XB_XCNT(j)]); sum += c; cnt += (c > 0u) ? 1u : 0u; mine = (j == x) ? c : mine; }
        if (sum == G) break;
        __builtin_amdgcn_s_sleep(1);
        if ((++sp & 255u) == 0u) { if (xb_ld(&bar[XB_TMO])) break; if (sp > XB_SPIN_CAP) { atomicAdd(&bar[XB_TMO], 1u); break; } }
    }
    nloc = mine > 0u ? mine : 1u; nx = cnt > 0u ? cnt : 1u;
}

__device__ __forceinline__ void xcd_barrier(const XcdBarrier& b) {
    asm volatile("s_waitcnt vmcnt(0)" ::: "memory");
    __syncthreads();
    if (threadIdx.x == 0) {
        unsigned* bar = b.bar;
        __builtin_amdgcn_s_waitcnt(0);
        unsigned nloc = b.st[0], nx = b.st[1];
        if (nloc == 0u) { xcd_barrier_complete(bar, b.x, nloc, nx); b.st[0] = nloc; b.st[1] = nx; }
        const unsigned old = xb_add(&bar[XB_XSUB(b.x)], 1u);
        const unsigned gen = old / nloc;
        if (old + 1u == (gen + 1u) * nloc) {
            __builtin_amdgcn_fence(__ATOMIC_RELEASE, "agent");
            asm volatile("s_waitcnt vmcnt(0)" ::: "memory");
            const unsigned og = xb_add(&bar[XB_TOP], 1u);
            const unsigned tg = og / nx;
            if (og + 1u == (tg + 1u) * nx) xb_add(&bar[XB_TOPGEN], 1u);
            else XB_SPIN(xb_ld(&bar[XB_TOPGEN]) == tg, bar);
            __builtin_amdgcn_fence(__ATOMIC_ACQUIRE, "agent");
            xb_add(&bar[XB_XGEN(b.x)], 1u);
            asm volatile("s_waitcnt vmcnt(0)" ::: "memory");
        } else {
            XB_SPIN(xb_ld(&bar[XB_XGEN(b.x)]) == gen, bar);
            __builtin_amdgcn_fence(__ATOMIC_ACQUIRE, "agent");
            asm volatile("s_waitcnt vmcnt(0)" ::: "memory");
        }
    }
    __syncthreads();
}

struct Args {
    const float* x;
    const float* ffn_norm[8]; const float* ffn_wi[8]; const float* ffn_wo[8];
    const float* mix_norm[4]; const float* mix_win[4]; const float* mix_wout[4];
    const float* mix_p0[4];
    const float* mix_p1[4];
    const float* mix_p2[4];
    const float* final_norm;
    float* out; unsigned char* ws; int ph_lo, ph_hi;
};
struct Frame {
    LAS unsigned char* lds;
    volatile LAS unsigned* MISC;
    gu32* ctl;
    int tid, lane, wave;
    int vcu, G;
};

__device__ __forceinline__ float wave_sum(float v) {
#pragma unroll
    for (int o = 1; o < 64; o <<= 1) v += __shfl_xor(v, o);
    return v;
}
__device__ __forceinline__ float bflo(unsigned w) { return __builtin_bit_cast(float, w << 16); }
__device__ __forceinline__ float bfhi(unsigned w) { return __builtin_bit_cast(float, w & 0xffff0000u); }
__device__ __forceinline__ void unpack8(const v4u w, float* f) {
    f[0] = bflo(w.x); f[1] = bfhi(w.x); f[2] = bflo(w.y); f[3] = bfhi(w.y); f[4] = bflo(w.z); f[5] = bfhi(w.z); f[6] = bflo(w.w); f[7] = bfhi(w.w);
}

__device__ __forceinline__ void transpose_item(const float* W, int ldw, int Kdst, bf16* WT, int k0, int n0, int drow0, LAS float* scr, int lane) {
#pragma unroll 8
    for (int i = 0; i < 32; ++i) { const int kk = 2 * i + (lane >> 5); scr[kk * 33 + (lane & 31)] = W[(size_t)(k0 + kk) * ldw + n0 + (lane & 31)]; }
    LDS_WAIT(); asm volatile("" ::: "memory");
    const int c = lane & 7;
#pragma unroll
    for (int j = 0; j < 4; ++j) { const int n = (lane >> 3) + 8 * j; const LAS float* s = scr + (8 * c) * 33 + n;
        v4u o; o.x = pk2(s[0 * 33], s[1 * 33]); o.y = pk2(s[2 * 33], s[3 * 33]); o.z = pk2(s[4 * 33], s[5 * 33]); o.w = pk2(s[6 * 33], s[7 * 33]);
        *(GAS v4u*)(WT + (size_t)(drow0 + n) * Kdst + k0 + 8 * c) = o; }
    LDS_WAIT(); asm volatile("" ::: "memory");
}
__device__ __forceinline__ void convert_matrix(Frame& F, const float* W, int ldw, int K, int Ncols, bf16* WT) {
    LAS float* scr = (LAS float*)(F.lds + RING_OFF + F.wave * 16384);
    const int gw = F.vcu * NWAVES + F.wave, NGW = F.G * NWAVES;
    const int nblk = Ncols / 32, items = (K / 64) * nblk;
    for (int it = gw; it < items; it += NGW) { const int kb = it / nblk, nb = it - kb * nblk; transpose_item(W, ldw, K, WT, 64 * kb, 32 * nb, 32 * nb, scr, F.lane); }
}
__device__ __forceinline__ void p0_prologue(Frame& F, const Args& a) {
    unsigned char* ws = a.ws;
    for (int s = 0; s < 8; ++s) {
        convert_matrix(F, a.ffn_wi[s], 2 * FF, D, 2 * FF, (bf16*)(ws + WS_W + s * WS_FFN_STRIDE));
        convert_matrix(F, a.ffn_wo[s], D, FF, D, (bf16*)(ws + WS_W + s * WS_FFN_STRIDE + WS_WO_OFF));
    }
    for (int L = 0; L < 4; ++L) {
        const int n = (L == 1) ? SWA_N : (L == 2) ? FOX_N : GM_N, ld = (L == 2) ? FOX_LD : n;
        convert_matrix(F, a.mix_win[L], ld, D, n, (bf16*)(ws + WS_MW + mw_win_off(L)));
        convert_matrix(F, a.mix_wout[L], D, D, D, (bf16*)(ws + WS_MW + mw_wout_off(L)));
    }
    { const GAS f32x4* s = (const GAS f32x4*)a.x; GAS f32x4* d = (GAS f32x4*)a.out; const size_t n4 = (size_t)M * D / 4;
      for (size_t i = (size_t)F.vcu * 512 + F.tid; i < n4; i += (size_t)F.G * 512) d[i] = s[i]; }
    { float* rope = (float*)(ws + WS_SMALL + 2 * MiB);
      for (int i = F.vcu * 512 + F.tid; i < SEQ * 8; i += F.G * 512) { const int s = i >> 3, j = i & 7;
          const float invf = exp2f(-(float)j * 0.125f * 18.931568569324174f);
          const float ang = (float)s * invf; double r = (double)ang * 0.15915494309189535; r -= rint(r); const float rf = (float)r;
          rope[s * 16 + j] = __builtin_amdgcn_cosf(rf); rope[s * 16 + 8 + j] = __builtin_amdgcn_sinf(rf); } }
}

template <int FOX> __device__ __forceinline__ void rms_phase(Frame& F, const float* h, const float* g, bf16* xn, const float* wf, const float* bfp, float* lgf) {
    const int gw = F.vcu * NWAVES + F.wave, NGW = F.G * NWAVES;
    LAS float* WL = (LAS float*)(F.lds + RING_OFF);
    if (FOX) {
        for (int i = F.tid; i < 2048 * 16; i += 512) { const int k = i >> 4, c = i & 15; WL[c * 2048 + k] = wf[(size_t)k * FOX_LD + FOX_N + c]; }
        __syncthreads();
    }
    f32x4 gv[8];
#pragma unroll
    for (int j = 0; j < 8; ++j) gv[j] = ((const GAS f32x4*)g)[F.lane + 64 * j];
    for (int m = gw; m < M; m += NGW) {
        const GAS f32x4* xr = (const GAS f32x4*)(h + (size_t)m * D) + F.lane;
        f32x4 v[8]; float s = 0.f;
#pragma unroll
        for (int j = 0; j < 8; ++j) { v[j] = xr[64 * j]; s += (v[j].x * v[j].x + v[j].y * v[j].y) + (v[j].z * v[j].z + v[j].w * v[j].w); }
        const float rstd = 1.f / sqrtf(wave_sum(s) * (1.f / D) + EPS);
        GAS unsigned long long* o8 = (GAS unsigned long long*)(xn + (size_t)m * D) + F.lane;
#pragma unroll
        for (int j = 0; j < 8; ++j) { v[j] = v[j] * rstd * gv[j]; o8[64 * j] = (unsigned long long)pk2(v[j].x, v[j].y) | ((unsigned long long)pk2(v[j].z, v[j].w) << 32); }
        if (FOX) {
            float mine = 0.f;
#pragma unroll 1
            for (int c = 0; c < 16; ++c) { float a = 0.f;
#pragma unroll
                for (int j = 0; j < 8; ++j) { const f32x4 w = *(const LAS f32x4*)(WL + c * 2048 + 4 * (F.lane + 64 * j)); a += (v[j].x * w.x + v[j].y * w.y) + (v[j].z * w.z + v[j].w * w.w); }
                a = wave_sum(a); mine = (F.lane == c) ? a : mine; }
            if (F.lane < 16) { const float xx = mine + bfp[F.lane]; lgf[(size_t)m * 16 + F.lane] = fminf(xx, 0.f) - log1pf(expf(-fabsf(xx))); }
        }
    }
    if (FOX) __syncthreads();
}
__device__ __forceinline__ void final_norm_phase(Frame& F, float* h, const float* g) {
    const int gw = F.vcu * NWAVES + F.wave, NGW = F.G * NWAVES;
    f32x4 gv[8];
#pragma unroll
    for (int j = 0; j < 8; ++j) gv[j] = ((const GAS f32x4*)g)[F.lane + 64 * j];
    for (int m = gw; m < M; m += NGW) {
        GAS f32x4* xr = (GAS f32x4*)(h + (size_t)m * D) + F.lane;
        f32x4 v[8]; float s = 0.f;
#pragma unroll
        for (int j = 0; j < 8; ++j) { v[j] = xr[64 * j]; s += (v[j].x * v[j].x + v[j].y * v[j].y) + (v[j].z * v[j].z + v[j].w * v[j].w); }
        const float rstd = 1.f / sqrtf(wave_sum(s) * (1.f / D) + EPS);
#pragma unroll
        for (int j = 0; j < 8; ++j) xr[64 * j] = v[j] * rstd * gv[j];
    }
}
__device__ __forceinline__ void silu_phase(Frame& F, const bf16* big, bf16* hid) {
    const size_t nv = (size_t)M * (FF / 8);
    for (size_t i = (size_t)F.vcu * 512 + F.tid; i < nv; i += (size_t)F.G * 512) {
        const size_t m = i / (FF / 8); const int j8 = (int)(i - m * (FF / 8));
        const v4u gw4 = *(const GAS v4u*)(big + m * (2 * FF) + 8 * j8), uw4 = *(const GAS v4u*)(big + m * (2 * FF) + FF + 8 * j8);
        float gf[8], uf[8], r[8]; unpack8(gw4, gf); unpack8(uw4, uf);
#pragma unroll
        for (int k = 0; k < 8; ++k) r[k] = gf[k] / (1.f + __expf(-gf[k])) * uf[k];
        v4u o; o.x = pk2(r[0], r[1]); o.y = pk2(r[2], r[3]); o.z = pk2(r[4], r[5]); o.w = pk2(r[6], r[7]);
        *(GAS v4u*)(hid + m * FF + 8 * j8) = o;
    }
}
__device__ __forceinline__ void gmlp_vstat_phase(Frame& F, const bf16* z, float* vstat) {
    const int gw = F.vcu * NWAVES + F.wave, NGW = F.G * NWAVES;
    for (int m = gw; m < M; m += NGW) {
        const GAS v4u* p = (const GAS v4u*)(z + (size_t)m * GM_N + 2048) + F.lane; float s = 0.f;
#pragma unroll
        for (int j = 0; j < 4; ++j) { float f[8]; unpack8(p[64 * j], f);
#pragma unroll
            for (int k = 0; k < 8; ++k) s += f[k] * f[k]; }
        s = wave_sum(s);
        if (F.lane == 0) vstat[m] = 1.f / sqrtf(s * (1.f / 2048.f) + EPS);
    }
}
__device__ __forceinline__ void gmlp_spatial_naive(Frame& F, const bf16* z, const float* vstat, const float* vg, const float* wsp, const float* bsp, bf16* y) {
    LAS float* WsT = (LAS float*)(F.lds + RING_OFF);
    LAS float* V = (LAS float*)(F.lds + RING_OFF + 65536);
    const int tt = F.tid >> 4, ww = F.tid & 15;
    for (int unit = F.vcu; unit < 2048; unit += F.G) {
        const int g = unit & 15, r0 = (unit >> 4) * 128;
        __syncthreads();
        for (int i = F.tid; i < 16384; i += 512) { const int t = i >> 7, s = i & 127; WsT[s * 128 + t] = (s <= t) ? wsp[(size_t)g * 16384 + i] : 0.f; }
        for (int i = F.tid; i < 16384; i += 512) { const int s = i >> 7, w = i & 127;
            const unsigned short b = z[(size_t)(r0 + s) * GM_N + 2048 + g * 128 + w];
            V[i] = __builtin_bit_cast(float, ((unsigned)b) << 16) * vstat[r0 + s] * vg[g * 128 + w]; }
        __syncthreads();
        float acc[4][8];
#pragma unroll
        for (int i = 0; i < 4; ++i)
#pragma unroll
            for (int j = 0; j < 8; ++j) acc[i][j] = 0.f;
        for (int s = 0; s < 128; ++s) {
            const f32x4 a = *(const LAS f32x4*)(WsT + s * 128 + tt * 4);
            const f32x4 v0 = *(const LAS f32x4*)(V + s * 128 + ww * 8), v1 = *(const LAS f32x4*)(V + s * 128 + ww * 8 + 4);
#pragma unroll
            for (int i = 0; i < 4; ++i) {
#pragma unroll
                for (int j = 0; j < 4; ++j) { acc[i][j] += a[i] * v0[j]; acc[i][4 + j] += a[i] * v1[j]; } }
        }
#pragma unroll
        for (int i = 0; i < 4; ++i) { const int t = tt * 4 + i; const size_t row = (size_t)(r0 + t); const float bias = bsp[g * 128 + t];
            float uf[8]; unpack8(*(const GAS v4u*)(z + row * GM_N + g * 128 + ww * 8), uf);
            v4u o; o.x = pk2(uf[0] * (acc[i][0] + bias), uf[1] * (acc[i][1] + bias)); o.y = pk2(uf[2] * (acc[i][2] + bias), uf[3] * (acc[i][3] + bias));
            o.z = pk2(uf[4] * (acc[i][4] + bias), uf[5] * (acc[i][5] + bias)); o.w = pk2(uf[6] * (acc[i][6] + bias), uf[7] * (acc[i][7] + bias));
            *(GAS v4u*)(y + row * D + g * 128 + ww * 8) = o; }
    }
    __syncthreads();
}
__device__ __forceinline__ void swa_naive(Frame& F, const bf16* qkv, const float* sinks, const float* rope, bf16* o) {
    const int gw = F.vcu * NWAVES + F.wave, NGW = F.G * NWAVES;
    for (int u = gw; u < 8192; u += NGW) {
        const int qb = u & 31, hq = (u >> 5) & 31, b = u >> 10, kv = hq >> 3;
        const int t = qb * 64 + F.lane; const size_t m = (size_t)b * SEQ + t;
        float q[64];
        { const GAS v4u* qp = (const GAS v4u*)(qkv + m * SWA_N + hq * 64);
#pragma unroll
          for (int i = 0; i < 8; ++i) unpack8(qp[i], q + 8 * i);
          const float* rp = rope + t * 16;
#pragma unroll
          for (int i = 0; i < 8; ++i) { const float c = rp[i], s = rp[8 + i], x1 = q[i], x2 = q[8 + i]; q[i] = x1 * c - x2 * s; q[8 + i] = x2 * c + x1 * s; }
#pragma unroll
          for (int i = 0; i < 64; ++i) q[i] *= 0.125f; }
        float acc[64];
#pragma unroll
        for (int i = 0; i < 64; ++i) acc[i] = 0.f;
        float mrun = sinks[hq], l = 1.f;
        const int s0 = (qb * 64 - 127) > 0 ? (qb * 64 - 127) : 0, s1 = qb * 64 + 63;
        for (int s = s0; s <= s1; ++s) {
            const size_t mk = (size_t)b * SEQ + s;
            const GAS v4u* kp = (const GAS v4u*)(qkv + mk * SWA_N + 2048 + kv * 64);
            float dot = 0.f;
            { float k0[16]; unpack8(kp[0], k0); unpack8(kp[1], k0 + 8);
              const float* rk = rope + s * 16;
#pragma unroll
              for (int i = 0; i < 8; ++i) { const float c = rk[i], sn = rk[8 + i], x1 = k0[i], x2 = k0[8 + i]; dot += q[i] * (x1 * c - x2 * sn) + q[8 + i] * (x2 * c + x1 * sn); } }
#pragma unroll
            for (int i = 2; i < 8; ++i) { float kf[8]; unpack8(kp[i], kf);
#pragma unroll
                for (int k = 0; k < 8; ++k) dot += q[8 * i + k] * kf[k]; }
            const bool valid = (s <= t) && (t - s < 128);
            if (valid) {
                if (dot > mrun) { const float corr = __expf(mrun - dot); l *= corr;
#pragma unroll
                    for (int i = 0; i < 64; ++i) acc[i] *= corr;
                    mrun = dot; }
                const float p = __expf(dot - mrun); l += p;
                const GAS v4u* vp = (const GAS v4u*)(qkv + mk * SWA_N + 2304 + kv * 64);
#pragma unroll
                for (int i = 0; i < 8; ++i) { float vf[8]; unpack8(vp[i], vf);
#pragma unroll
                    for (int k = 0; k < 8; ++k) acc[8 * i + k] += p * vf[k]; }
            }
        }
        const float inv = 1.f / l;
        GAS v4u* op = (GAS v4u*)(o + m * D + hq * 64);
#pragma unroll
        for (int i = 0; i < 8; ++i) { v4u w; w.x = pk2(acc[8 * i] * inv, acc[8 * i + 1] * inv); w.y = pk2(acc[8 * i + 2] * inv, acc[8 * i + 3] * inv);
            w.z = pk2(acc[8 * i + 4] * inv, acc[8 * i + 5] * inv); w.w = pk2(acc[8 * i + 6] * inv, acc[8 * i + 7] * inv); op[i] = w; }
    }
}
__device__ __forceinline__ void fox_cumsum_phase(Frame& F, float* dec) {
    const int gw = F.vcu * NWAVES + F.wave, NGW = F.G * NWAVES;
    for (int p = gw; p < BATCH * 16; p += NGW) {
        const int b = p >> 4, hh = p & 15;
        float* base = dec + ((size_t)b * SEQ + 32 * F.lane) * 16 + hh;
        float v[32]; float run = 0.f;
#pragma unroll
        for (int i = 0; i < 32; ++i) { run += base[i * 16]; v[i] = run; }
        float incl = run;
#pragma unroll
        for (int o = 1; o < 64; o <<= 1) { const float t = __shfl_up(incl, o); if (F.lane >= o) incl += t; }
        const float excl = incl - run;
#pragma unroll
        for (int i = 0; i < 32; ++i) base[i * 16] = v[i] + excl;
    }
}
__device__ __forceinline__ void fox_naive(Frame& F, const bf16* qkv, const float* dec, bf16* o) {
    const int gw = F.vcu * NWAVES + F.wave, NGW = F.G * NWAVES;
    const int qi = F.lane & 31, half = F.lane >> 5;
    for (int u = gw; u < 8192; u += NGW) {
        const int b = u >> 10, hh = (u >> 6) & 15; int qb = u & 63; if ((b >> 1) & 1) qb = 63 - qb;
        const int t = qb * 32 + qi; const size_t m = (size_t)b * SEQ + t;
        float q[64];
        { const GAS v4u* qp = (const GAS v4u*)(qkv + m * FOX_N + hh * 128 + half * 64);
#pragma unroll
          for (int i = 0; i < 8; ++i) unpack8(qp[i], q + 8 * i);
#pragma unroll
          for (int i = 0; i < 64; ++i) q[i] *= 0.08838834764831845f; }
        const float Dt = dec[m * 16 + hh];
        float acc[64];
#pragma unroll
        for (int i = 0; i < 64; ++i) acc[i] = 0.f;
        float mrun = -1e30f, l = 0.f;
        const int s1 = qb * 32 + 31;
        for (int s = 0; s <= s1; ++s) {
            const size_t mk = (size_t)b * SEQ + s;
            const GAS v4u* kp = (const GAS v4u*)(qkv + mk * FOX_N + 2048 + hh * 128 + half * 64);
            float dot = 0.f;
#pragma unroll
            for (int i = 0; i < 8; ++i) { float kf[8]; unpack8(kp[i], kf);
#pragma unroll
                for (int k = 0; k < 8; ++k) dot += q[8 * i + k] * kf[k]; }
            dot += __shfl_xor(dot, 32);
            const float sc = dot + (Dt - dec[mk * 16 + hh]);
            if (s <= t) {
                if (sc > mrun) { const float corr = __expf(mrun - sc); l *= corr;
#pragma unroll
                    for (int i = 0; i < 64; ++i) acc[i] *= corr;
                    mrun = sc; }
                const float p = __expf(sc - mrun); l += p;
                const GAS v4u* vp = (const GAS v4u*)(qkv + mk * FOX_N + 4096 + hh * 128 + half * 64);
#pragma unroll
                for (int i = 0; i < 8; ++i) { float vf[8]; unpack8(vp[i], vf);
#pragma unroll
                    for (int k = 0; k < 8; ++k) acc[8 * i + k] += p * vf[k]; }
            }
        }
        const float inv = 1.f / l;
        GAS v4u* op = (GAS v4u*)(o + m * D + hh * 128 + half * 64);
#pragma unroll
        for (int i = 0; i < 8; ++i) { v4u w; w.x = pk2(acc[8 * i] * inv, acc[8 * i + 1] * inv); w.y = pk2(acc[8 * i + 2] * inv, acc[8 * i + 3] * inv);
            w.z = pk2(acc[8 * i + 4] * inv, acc[8 * i + 5] * inv); w.w = pk2(acc[8 * i + 6] * inv, acc[8 * i + 7] * inv); op[i] = w; }
    }
}

__global__ void __launch_bounds__(NWAVES * 64, 2) mk_fwd(Args args) {
    extern __shared__ __attribute__((aligned(16))) unsigned char lds[];
    Frame F;
    F.lds = (LAS unsigned char*)lds;
    F.MISC = (volatile LAS unsigned*)(F.lds + MISC_OFF);
    F.tid = threadIdx.x; F.lane = F.tid & 63; F.wave = __builtin_amdgcn_readfirstlane(F.tid >> 6);
    F.G = gridDim.x; { const int bx = blockIdx.x; F.vcu = (F.G % 8 == 0) ? (bx % 8) * (F.G / 8) + bx / 8 : bx; }
    unsigned char* ws = args.ws;
    F.ctl = (gu32*)(ws + WS_CTL);
    for (int u = F.tid; u < (LDS_BYTES - LDSCTL_OFF) / 4; u += NWAVES * 64) ((LAS unsigned*)(F.lds + LDSCTL_OFF))[u] = 0u;
    __syncthreads();
    const int lo = args.ph_lo, hi = args.ph_hi;
    XcdBarrier bar; bar.bar = (unsigned*)(F.ctl + CW_BAR); bar.x = 0; bar.st = nullptr;
    if (hi - lo > 1) bar = xcd_barrier_post((unsigned*)(F.ctl + CW_BAR), F.MISC + 8);
    int ph = 0;
#define PH_BEGIN if (lo <= ph && ph < hi) { asm volatile("" : "+v"(F.tid), "+v"(F.lane), "+s"(F.wave), "+s"(F.vcu));
#define PH_END   if (ph + 1 < hi) xcd_barrier(bar); } ++ph;

    float* const h = args.out;
    bf16* const XN = (bf16*)(ws + WS_XN); bf16* const BIG = (bf16*)(ws + WS_BIG); bf16* const HID = (bf16*)(ws + WS_HID);
    float* const VSTAT = (float*)(ws + WS_SMALL); float* const DEC = (float*)(ws + WS_SMALL + 1 * MiB); const float* const ROPE = (const float*)(ws + WS_SMALL + 2 * MiB);

    PH_BEGIN p0_prologue(F, args); PH_END

    for (int sl = 0; sl < 8; ++sl) {
        PH_BEGIN rms_phase<0>(F, h, args.ffn_norm[sl], XN, nullptr, nullptr, nullptr); PH_END
        PH_BEGIN { pg8::Gemm g{XN, (const bf16*)(ws + WS_W + sl * WS_FFN_STRIDE), M, 2 * FF, D}; pg8::StaticOrder S; S.init(M, 2 * FF, F.G, (int)blockIdx.x);
                   pg8::EpiBf16<0> E{BIG, 2 * FF, nullptr, 0, 0, 1.f};
                   pg8::gemm_phase<pg8::EpiBf16<0>, pg8::StaticOrder, true, true>(F.lds + RING_OFF, g, S, E); } PH_END
        PH_BEGIN silu_phase(F, BIG, HID); PH_END
        PH_BEGIN { pg8::Gemm g{HID, (const bf16*)(ws + WS_W + sl * WS_FFN_STRIDE + WS_WO_OFF), M, D, FF}; pg8::StaticOrder S; S.init(M, D, F.G, (int)blockIdx.x);
                   pg8::EpiResid E{h, D, 0.5f};
                   pg8::gemm_phase<pg8::EpiResid, pg8::StaticOrder, true, true>(F.lds + RING_OFF, g, S, E); } PH_END
        if (sl & 1) continue;
        const int L = sl >> 1;
        const bf16* win_t = (const bf16*)(ws + WS_MW + mw_win_off(L)); const bf16* wout_t = (const bf16*)(ws + WS_MW + mw_wout_off(L));
        if (L == 0 || L == 3) {
            PH_BEGIN rms_phase<0>(F, h, args.mix_norm[L], XN, nullptr, nullptr, nullptr); PH_END
            PH_BEGIN { pg8::Gemm g{XN, win_t, M, GM_N, D}; pg8::StaticOrder S; S.init(M, GM_N, F.G, (int)blockIdx.x);
                       pg8::EpiBf16<1> E{BIG, GM_N, nullptr, 0, 0, 1.f};
                       pg8::gemm_phase<pg8::EpiBf16<1>, pg8::StaticOrder, true, true>(F.lds + RING_OFF, g, S, E); } PH_END
            PH_BEGIN gmlp_vstat_phase(F, BIG, VSTAT); PH_END
            PH_BEGIN gmlp_spatial_naive(F, BIG, VSTAT, args.mix_p0[L], args.mix_p1[L], args.mix_p2[L], HID); PH_END
        } else if (L == 1) {
            PH_BEGIN rms_phase<0>(F, h, args.mix_norm[L], XN, nullptr, nullptr, nullptr); PH_END
            PH_BEGIN { pg8::Gemm g{XN, win_t, M, SWA_N, D}; pg8::StaticOrder S; S.init(M, SWA_N, F.G, (int)blockIdx.x);
                       pg8::EpiBf16<0> E{BIG, SWA_N, nullptr, 0, 0, 1.f};
                       pg8::gemm_phase<pg8::EpiBf16<0>, pg8::StaticOrder, true, true>(F.lds + RING_OFF, g, S, E); } PH_END
            PH_BEGIN swa_naive(F, BIG, args.mix_p0[L], ROPE, HID); PH_END
        } else {
            PH_BEGIN rms_phase<1>(F, h, args.mix_norm[L], XN, args.mix_win[L], args.mix_p0[L], DEC); PH_END
            PH_BEGIN { pg8::Gemm g{XN, win_t, M, FOX_N, D}; pg8::StaticOrder S; S.init(M, FOX_N, F.G, (int)blockIdx.x);
                       pg8::EpiBf16<0> E{BIG, FOX_N, nullptr, 0, 0, 1.f};
                       pg8::gemm_phase<pg8::EpiBf16<0>, pg8::StaticOrder, true, true>(F.lds + RING_OFF, g, S, E); } PH_END
            PH_BEGIN fox_cumsum_phase(F, DEC); PH_END
            PH_BEGIN fox_naive(F, BIG, DEC, HID); PH_END
        }
        PH_BEGIN { pg8::Gemm g{HID, wout_t, M, D, D}; pg8::StaticOrder S; S.init(M, D, F.G, (int)blockIdx.x);
                   pg8::EpiResid E{h, D, 1.0f};
                   pg8::gemm_phase<pg8::EpiResid, pg8::StaticOrder, true, true>(F.lds + RING_OFF, g, S, E); } PH_END
    }
    PH_BEGIN final_norm_phase(F, h, args.final_norm); PH_END
#undef PH_BEGIN
#undef PH_END
}
constexpr int NPH = 1 + 8 * 4 + (5 + 4 + 5 + 5) + 1;

extern "C" void kernel_launch(void* const* d_in, const int* in_sizes, int n_in, void* d_out, int out_size, void* d_ws, size_t ws_size, hipStream_t stream) {
    static int grid = 0;
    if (grid == 0) {
        if (n_in != 46 || in_sizes[0] != M * D || out_size != M * D || ws_size < WS_END) { fprintf(stderr, "kernel_launch: unexpected shapes: n_in %d in0 %d out %d ws %zu (need %zu)\n", n_in, n_in > 0 ? in_sizes[0] : -1, out_size, ws_size, (size_t)WS_END); grid = -1; return; }
        int dev = 0, cus = 0;
        if (hipGetDevice(&dev) != hipSuccess || hipDeviceGetAttribute(&cus, hipDeviceAttributeMultiprocessorCount, dev) != hipSuccess) { grid = -1; return; }
        if (hipFuncSetAttribute((const void*)mk_fwd, hipFuncAttributeMaxDynamicSharedMemorySize, LDS_BYTES) != hipSuccess) { fprintf(stderr, "kernel_launch: hipFuncSetAttribute failed\n"); grid = -1; return; }
        (void)hipGetLastError();
        grid = cus;
    }
    if (grid < 0) return;
    if (hipMemsetAsync((char*)d_ws + WS_CTL, 0, CTL_ZERO_BYTES, stream) != hipSuccess) return;
    Args a{};
    a.x = (const float*)d_in[0];
    const int base[4] = {1, 13, 23, 33};
    for (int L = 0; L < 4; ++L) {
        const int b = base[L]; const bool gm = (L == 0 || L == 3);
        a.ffn_norm[2 * L] = (const float*)d_in[b]; a.ffn_wi[2 * L] = (const float*)d_in[b + 1]; a.ffn_wo[2 * L] = (const float*)d_in[b + 2];
        a.mix_norm[L] = (const float*)d_in[b + 3]; a.mix_win[L] = (const float*)d_in[b + 4];
        a.mix_p0[L] = (const float*)d_in[b + 5];
        int nx = b + 6;
        if (gm) { a.mix_p1[L] = (const float*)d_in[b + 6]; a.mix_p2[L] = (const float*)d_in[b + 7]; nx = b + 8; }
        a.mix_wout[L] = (const float*)d_in[nx];
        a.ffn_norm[2 * L + 1] = (const float*)d_in[nx + 1]; a.ffn_wi[2 * L + 1] = (const float*)d_in[nx + 2]; a.ffn_wo[2 * L + 1] = (const float*)d_in[nx + 3];
    }
    a.final_norm = (const float*)d_in[45];
    a.out = (float*)d_out; a.ws = (unsigned char*)d_ws;
#if MK_N_LAUNCHES == 1
    a.ph_lo = 0; a.ph_hi = NPH;
    hipLaunchKernelGGL(mk_fwd, dim3(grid), dim3(NWAVES * 64), LDS_BYTES, stream, a);
#else
    for (int p = 0; p < NPH; ++p) { a.ph_lo = p; a.ph_hi = p + 1; hipLaunchKernelGGL(mk_fwd, dim3(grid), dim3(NWAVES * 64), LDS_BYTES, stream, a); }
#endif
}
```

```cpp
#include <hip/hip_runtime.h>
#include <cstdio>
#include <cstdint>
namespace pg8 {
#define PG8_LAS __attribute__((address_space(3)))
typedef unsigned short bf16_t;
typedef short bf16x8 __attribute__((ext_vector_type(8)));
typedef float f32x4 __attribute__((ext_vector_type(4)));
typedef unsigned u32x4 __attribute__((ext_vector_type(4)));
constexpr int BM = 256, BK = 64, HALF = 128, HTB = HALF * BK * 2  , STAGE_BYTES = 8 * HTB, NXCD = 8, WGM = 8;

__host__ __device__ __forceinline__ int lds_byte(int r, int c) { const int st = (r >> 4) * 2 + (c >> 5), rr = r & 15, cc = c & 31, ob = rr * 64 + cc * 2; return st * 1024 + (ob ^ (((ob >> 9) & 1) << 5)); }
__host__ __device__ __forceinline__ void stage_rc(int b, int& R, int& C) { const int st = b / 1024, sb = b % 1024, swz = sb ^ (((sb >> 9) & 1) << 5); R = (st >> 1) * 16 + swz / 64; C = (st & 1) * 32 + (swz % 64) / 2; }
__host__ __device__ __forceinline__ int perm32(int rho) { const int n = rho >> 4, i = rho & 15; return 8 * (i >> 2) + 4 * n + (i & 3); }

struct Unit { int pm, pn; };
struct Gemm { const bf16_t* A; const bf16_t* Bt; int M, N, K; };

struct StaticOrder {
    int nM, nN, nwg, G, c, wgm;
    __host__ __device__ void init(int M, int N, int G_, int c_, int wgm_ = WGM) { nM = M / BM; nN = N / BM; nwg = nM * nN; G = G_; c = c_; wgm = wgm_; }
    __host__ __device__ bool next(int i, Unit& u) const {
        const long L = (long)i * G + c; if (L >= nwg) return false;
        int wgid = (int)L; { const int q = nwg / NXCD, r = nwg % NXCD, xcd = wgid % NXCD, off = wgid / NXCD; wgid = (xcd < r ? xcd * (q + 1) : r * (q + 1) + (xcd - r) * q) + off; }
        const int nig = wgm * nN, gid = wgid / nig, fm = gid * wgm, gsz = (nM - fm) < wgm ? (nM - fm) : wgm;
        u.pm = fm + ((wgid % nig) % gsz); u.pn = (wgid % nig) / gsz; return true;
    }
    __device__ __forceinline__ void a_ready(const Unit&) const {}
    __device__ __forceinline__ void done(const Unit&) const {}
};

__device__ __forceinline__ unsigned cvt_pk_bf16(float lo, float hi) { unsigned r; asm volatile("v_cvt_pk_bf16_f32 %0, %1, %2" : "=v"(r) : "v"(lo), "v"(hi)); return r; }
typedef float f32x2 __attribute__((ext_vector_type(2)));
__device__ __forceinline__ f32x2 gelu_pk(f32x2 v) {
    const f32x2 av = __builtin_elementwise_abs(v), d = av * 0.2316418882f + 1.0f;
    f32x2 t; t.x = __builtin_amdgcn_rcpf(d.x); t.y = __builtin_amdgcn_rcpf(d.y);
    f32x2 q = t * 0.5307027145f + (-0.7265760135f); q = q * t + 0.7107068705f; q = q * t + (-0.142248368f); q = q * t + 0.127414796f; q = q * t;
    const f32x2 s = (v * v) * (-0.72134752044f);
    f32x2 e; e.x = __builtin_amdgcn_exp2f(s.x); e.y = __builtin_amdgcn_exp2f(s.y);
    const f32x2 m = v * (q * e), r = v - m;
    f32x2 o; o.x = v.x < 0.f ? m.x : r.x; o.y = v.y < 0.f ? m.y : r.y; return o;
}

template <int ACT  > struct EpiBf16 {
    static constexpr bool PERM = true, AFTER_DRAIN = false; static_assert(ACT == 0 || ACT == 1, "EpiBf16: ACT is 0 (none) or 1 (gelu_pk)");
    bf16_t* O; int ldc; const float* bias; int split_cols; size_t split_stride; float scale0;
    __device__ __forceinline__ void operator()(const f32x4 (&acc)[2][2][4][2], const Unit& u, int wr, int wc, int fr, int fq) const {
        const int row0 = u.pm * BM + wr * 64 + fr; int colt = u.pn * BM; bf16_t* base = O;
        float sc = 1.f; if (split_cols) { const int t = colt / split_cols; base += (size_t)t * split_stride; colt -= t * split_cols; if (t == 0) sc = scale0; }
        const int col0 = colt + wc * 32 + 8 * fq, bcol0 = u.pn * BM + wc * 32 + 8 * fq;
        f32x4 bv[2][2];
#pragma unroll
        for (int bj = 0; bj < 2; ++bj)
#pragma unroll
            for (int n = 0; n < 2; ++n) bv[bj][n] = bias ? *(const f32x4*)(bias + bcol0 + bj * HALF + 4 * n) : (f32x4){0.f, 0.f, 0.f, 0.f};
#pragma unroll
        for (int ai = 0; ai < 2; ++ai)
#pragma unroll
            for (int m = 0; m < 4; ++m) { bf16_t* rowp = base + (size_t)(row0 + ai * HALF + m * 16) * ldc + col0;
#pragma unroll
                for (int bj = 0; bj < 2; ++bj) { f32x4 v0 = acc[ai][bj][m][0] + bv[bj][0], v1 = acc[ai][bj][m][1] + bv[bj][1];
                    if (ACT == 1) { f32x2 a = gelu_pk((f32x2){v0[0], v0[1]}), b = gelu_pk((f32x2){v0[2], v0[3]}), c = gelu_pk((f32x2){v1[0], v1[1]}), d = gelu_pk((f32x2){v1[2], v1[3]});
                        v0 = (f32x4){a.x, a.y, b.x, b.y}; v1 = (f32x4){c.x, c.y, d.x, d.y}; }
                    v0 = v0 * sc; v1 = v1 * sc; u32x4 w; w.x = cvt_pk_bf16(v0[0], v0[1]); w.y = cvt_pk_bf16(v0[2], v0[3]); w.z = cvt_pk_bf16(v1[0], v1[1]); w.w = cvt_pk_bf16(v1[2], v1[3]);
                    *(u32x4*)(rowp + bj * HALF) = w; } }
    }
};
template <class Epi, class Sched, bool ALIGN_EPI = false, bool SP2 = false>
__device__ __forceinline__ void gemm_phase(PG8_LAS unsigned char* lds, const Gemm g, const Sched& S, const Epi& E) {
    int tid_l = threadIdx.x; asm volatile("" : "+v"(tid_l));
    const int tid = tid_l, wid = __builtin_amdgcn_readfirstlane(tid >> 6), lane = tid & 63, wr = wid >> 2, wc = wid & 3, fr = lane & 15, fq = lane >> 4;
    const int K = g.K, nt = K / BK;
    unsigned voffA[2], voffB[2];
#pragma unroll
    for (int i = 0; i < 2; ++i) { int R, C; stage_rc(tid * 16 + i * 8192, R, C); const int Rb = Epi::PERM ? ((R & ~31) + perm32(R & 31)) : R;
        voffA[i] = (unsigned)(R * K + C) * 2u; voffB[i] = (unsigned)(Rb * BK + C) * 2u; }
    const size_t kstep = (size_t)(BK * 2);
    const size_t hstep = (size_t)HALF * K * 2;
    const size_t tstep = 2 * hstep;
    const size_t kstepB = (size_t)BM * BK * 2, hstepB = (size_t)HALF * BK * 2, tstepB = (size_t)nt * kstepB;
    const unsigned ldsw = (unsigned)wid * 1024u;
    const int aoff = lds_byte(wr * 64 + fr, fq * 8), boff = lds_byte(wc * 32 + fr, fq * 8);
#define PG8_SA(b, h) (((b) * 2 + (h)) * HTB)
#define PG8_SB(b, h) ((4 + (b) * 2 + (h)) * HTB)
#define PG8_STAGE(bufoff, gbase, voff) do { _Pragma("unroll") for (int _i = 0; _i < 2; ++_i) \
        __builtin_amdgcn_global_load_lds((const unsigned*)((const char*)(gbase) + (voff)[_i]), (PG8_LAS unsigned*)(lds + (bufoff) + ldsw + _i * 8192), 16, 0, 0); } while (0)
#define PG8_LDA(dst, b, h) do { _Pragma("unroll") for (int m = 0; m < 4; ++m) _Pragma("unroll") for (int k = 0; k < 2; ++k) dst[m][k] = *(const PG8_LAS bf16x8*)(lds + PG8_SA(b, h) + aoff + m * 2048 + k * 1024); } while (0)
#define PG8_LDB(dst, b, h) do { _Pragma("unroll") for (int n = 0; n < 2; ++n) _Pragma("unroll") for (int k = 0; k < 2; ++k) dst[n][k] = *(const PG8_LAS bf16x8*)(lds + PG8_SB(b, h) + boff + n * 2048 + k * 1024); } while (0)
#define PG8_MMA(ai, bj, At, Bt) do { __builtin_amdgcn_s_setprio(1); _Pragma("unroll") for (int m = 0; m < 4; ++m) _Pragma("unroll") for (int n = 0; n < 2; ++n) _Pragma("unroll") for (int k = 0; k < 2; ++k) \
        acc[ai][bj][m][n] = __builtin_amdgcn_mfma_f32_16x16x32_bf16(Bt[n][k], At[m][k], acc[ai][bj][m][n], 0, 0, 0); __builtin_amdgcn_s_setprio(0); } while (0)
#define PG8_WAIT_V(n) asm volatile("s_waitcnt vmcnt(" #n ")" ::: "memory")
#define PG8_WAIT_L(n) asm volatile("s_waitcnt lgkmcnt(" #n ")" ::: "memory")
#define PG8_BAR __builtin_amdgcn_s_barrier()
#define PG8_SCHED __builtin_amdgcn_sched_barrier(0)
    Unit cur, nxt; int ui = 0;
    if (!S.next(0, cur)) return;
    f32x4 acc[2][2][4][2];
#pragma unroll
    for (int a = 0; a < 2; ++a)
#pragma unroll
        for (int b = 0; b < 2; ++b)
#pragma unroll
            for (int m = 0; m < 4; ++m)
#pragma unroll
                for (int n = 0; n < 2; ++n) acc[a][b][m][n] = (f32x4){0.f, 0.f, 0.f, 0.f};
    bf16x8 At[4][2], B0[2][2], B1[2][2];
    const char* cA = (const char*)g.A + (size_t)cur.pm * tstep; const char* cB = (const char*)g.Bt + (size_t)cur.pn * tstepB;
    S.a_ready(cur);
    if constexpr (SP2) {
        PG8_STAGE(PG8_SB(0, 0), cB, voffB); PG8_STAGE(PG8_SB(0, 1), cB + hstepB, voffB); PG8_STAGE(PG8_SA(0, 0), cA, voffA); PG8_STAGE(PG8_SA(0, 1), cA + hstep, voffA);
        if (wr == 1) PG8_BAR;
        PG8_WAIT_V(2); PG8_BAR;
        PG8_STAGE(PG8_SB(1, 0), cB + kstepB, voffB); PG8_STAGE(PG8_SA(1, 0), cA + kstep, voffA); PG8_STAGE(PG8_SB(1, 1), cB + hstepB + kstepB, voffB);
        PG8_WAIT_V(6); PG8_BAR;
    } else {
        PG8_STAGE(PG8_SB(0, 0), cB, voffB); PG8_STAGE(PG8_SA(0, 0), cA, voffA); PG8_STAGE(PG8_SB(0, 1), cB + hstepB, voffB); PG8_STAGE(PG8_SA(0, 1), cA + hstep, voffA);
        if (wr == 1) PG8_BAR;
        PG8_WAIT_V(4); PG8_BAR;
        PG8_STAGE(PG8_SB(1, 0), cB + kstepB, voffB); PG8_STAGE(PG8_SA(1, 0), cA + kstep, voffA); PG8_STAGE(PG8_SB(1, 1), cB + hstepB + kstepB, voffB);
        PG8_WAIT_V(6); PG8_BAR;
    }
    for (;;) {
        const bool has_next = S.next(ui + 1, nxt);
        const char* nA = has_next ? (const char*)g.A + (size_t)nxt.pm * tstep : cA; const char* nB = has_next ? (const char*)g.Bt + (size_t)nxt.pn * tstepB : cB;
        for (int t = 0; t < nt; t += 2) {
            const bool last = (t == nt - 2);
            const char* a1 = cA + (size_t)(t + 1) * kstep;
            const char* a2 = last ? nA : cA + (size_t)(t + 2) * kstep; const char* b2 = last ? nB : cB + (size_t)(t + 2) * kstepB;
            const char* a3 = a2 + kstep; const char* b3 = b2 + kstepB;
            if (last && has_next) S.a_ready(nxt);
            if constexpr (SP2) {
            PG8_LDB(B0, 0, 0); PG8_LDB(B1, 0, 1); PG8_SCHED; PG8_LDA(At, 0, 0); PG8_STAGE(PG8_SA(1, 1), a1 + hstep, voffA);
            PG8_WAIT_V(8); PG8_WAIT_L(0); PG8_BAR; PG8_MMA(0, 0, At, B0); PG8_MMA(0, 1, At, B1); PG8_BAR; PG8_SCHED;
            PG8_LDA(At, 0, 1); PG8_STAGE(PG8_SB(0, 0), b2, voffB); PG8_STAGE(PG8_SB(0, 1), b2 + hstepB, voffB); PG8_STAGE(PG8_SA(0, 0), a2, voffA);
            PG8_WAIT_V(8); PG8_WAIT_L(0); PG8_BAR; PG8_MMA(1, 0, At, B0); PG8_MMA(1, 1, At, B1); PG8_BAR; PG8_SCHED;
            PG8_LDB(B0, 1, 0); PG8_LDB(B1, 1, 1); PG8_SCHED; PG8_LDA(At, 1, 0); PG8_STAGE(PG8_SA(0, 1), a2 + hstep, voffA);
            PG8_WAIT_V(8); PG8_WAIT_L(0); PG8_BAR; PG8_MMA(0, 0, At, B0); PG8_MMA(0, 1, At, B1); PG8_BAR; PG8_SCHED;
            PG8_LDA(At, 1, 1); PG8_STAGE(PG8_SB(1, 0), b3, voffB); PG8_STAGE(PG8_SB(1, 1), b3 + hstepB, voffB); PG8_STAGE(PG8_SA(1, 0), a3, voffA);
            PG8_WAIT_V(8); PG8_WAIT_L(0); PG8_BAR; PG8_MMA(1, 0, At, B0); PG8_MMA(1, 1, At, B1); PG8_BAR; PG8_SCHED;
            } else {
            PG8_LDB(B0, 0, 0); PG8_SCHED; PG8_LDA(At, 0, 0); PG8_STAGE(PG8_SA(1, 1), a1 + hstep, voffA);
            PG8_WAIT_L(8); PG8_BAR; PG8_WAIT_L(0); PG8_MMA(0, 0, At, B0); PG8_BAR; PG8_SCHED;
            PG8_LDB(B1, 0, 1); PG8_STAGE(PG8_SB(0, 0), b2, voffB);
            PG8_BAR; PG8_WAIT_L(0); PG8_MMA(0, 1, At, B1); PG8_BAR;
            PG8_LDA(At, 0, 1); PG8_STAGE(PG8_SA(0, 0), a2, voffA);
            PG8_BAR; PG8_WAIT_L(0); PG8_MMA(1, 0, At, B0); PG8_BAR; PG8_SCHED;
            PG8_STAGE(PG8_SB(0, 1), b2 + hstepB, voffB);
            PG8_WAIT_V(6); PG8_BAR; PG8_MMA(1, 1, At, B1); PG8_BAR;
            PG8_LDB(B0, 1, 0); PG8_SCHED; PG8_LDA(At, 1, 0); PG8_STAGE(PG8_SA(0, 1), a2 + hstep, voffA);
            PG8_WAIT_L(8); PG8_BAR; PG8_WAIT_L(0); PG8_MMA(0, 0, At, B0); PG8_BAR; PG8_SCHED;
            PG8_LDB(B1, 1, 1); PG8_STAGE(PG8_SB(1, 0), b3, voffB);
            PG8_BAR; PG8_WAIT_L(0); PG8_MMA(0, 1, At, B1); PG8_BAR;
            PG8_LDA(At, 1, 1); PG8_STAGE(PG8_SA(1, 0), a3, voffA);
            PG8_BAR; PG8_WAIT_L(0); PG8_MMA(1, 0, At, B0); PG8_BAR; PG8_SCHED;
            PG8_STAGE(PG8_SB(1, 1), b3 + hstepB, voffB);
            PG8_WAIT_V(6); PG8_BAR; PG8_MMA(1, 1, At, B1); PG8_BAR;
            }
        }
        if constexpr (ALIGN_EPI) { if (wr == 0) PG8_BAR; }
        if constexpr (!Epi::AFTER_DRAIN) { E(acc, cur, wr, wc, fr, fq); S.done(cur); }
        if (!has_next) break;
#pragma unroll
        for (int a = 0; a < 2; ++a)
#pragma unroll
            for (int b = 0; b < 2; ++b)
#pragma unroll
                for (int m = 0; m < 4; ++m)
#pragma unroll
                    for (int n = 0; n < 2; ++n) acc[a][b][m][n] = (f32x4){0.f, 0.f, 0.f, 0.f};
        cur = nxt; cA = nA; cB = nB; ++ui;
        if constexpr (ALIGN_EPI) { if (wr == 1) PG8_BAR; }
    }
    PG8_WAIT_V(0);
    if constexpr (!ALIGN_EPI) { if (wr == 0) PG8_BAR; }
    PG8_BAR;
    if constexpr (Epi::AFTER_DRAIN) { E.fused(acc, cur, wr, wc, fr, fq, lds, wid, lane); S.done(cur); }
#undef PG8_SA
#undef PG8_SB
#undef PG8_STAGE
#undef PG8_LDA
#undef PG8_LDB
#undef PG8_MMA
#undef PG8_WAIT_V
#undef PG8_WAIT_L
#undef PG8_BAR
#undef PG8_SCHED
}
}
namespace pg8 {
typedef unsigned u32x2 __attribute__((ext_vector_type(2)));
struct EpiResid {
    static constexpr bool PERM = true, AFTER_DRAIN = false;
    bf16_t* HB; float* part; int ldc; float coef;
    __device__ __forceinline__ void operator()(const f32x4 (&acc)[2][2][4][2], const Unit& u, int wr, int wc, int fr, int fq) const {
        const int row0 = u.pm * BM + wr * 64 + fr, col0 = u.pn * BM + wc * 32 + 8 * fq;
        u32x4 o[2][4][2];
#pragma unroll
        for (int ai = 0; ai < 2; ++ai)
#pragma unroll
            for (int m = 0; m < 4; ++m) { const bf16_t* rowp = HB + (size_t)(row0 + ai * HALF + m * 16) * ldc + col0;
#pragma unroll
                for (int bj = 0; bj < 2; ++bj) o[ai][m][bj] = *(const u32x4*)(rowp + bj * HALF); }
        asm volatile("" ::: "memory");
#pragma unroll
        for (int ai = 0; ai < 2; ++ai) {
            float smine = 0.f;
#pragma unroll
            for (int m = 0; m < 4; ++m) { bf16_t* rowp = HB + (size_t)(row0 + ai * HALF + m * 16) * ldc + col0; float s = 0.f;
#pragma unroll
                for (int bj = 0; bj < 2; ++bj) { const u32x4 w0 = o[ai][m][bj]; u32x4 w;
#pragma unroll
                    for (int k = 0; k < 4; ++k) { const float a0 = __builtin_bit_cast(float, w0[k] << 16) + acc[ai][bj][m][k >> 1][2 * (k & 1)] * coef, a1 = __builtin_bit_cast(float, w0[k] & 0xffff0000u) + acc[ai][bj][m][k >> 1][2 * (k & 1) + 1] * coef;
                        const unsigned pk = cvt_pk_bf16(a0, a1); w[k] = pk; const float r0 = __builtin_bit_cast(float, pk << 16), r1 = __builtin_bit_cast(float, pk & 0xffff0000u); s += r0 * r0 + r1 * r1; }
                    *(u32x4*)(rowp + bj * HALF) = w; }
                s += __shfl_xor(s, 16); s += __shfl_xor(s, 32);
                smine = (fq == m) ? s : smine; }
            part[(size_t)(row0 + ai * HALF + fq * 16) * 32 + u.pn * 4 + wc] = smine;
        }
    }
};
struct EpiSwiGLU {
    static constexpr bool PERM = true, AFTER_DRAIN = false;
    bf16_t* O; int ldc; const PG8_LAS float* rs;
    __device__ __forceinline__ static unsigned silu_mul_pk(f32x2 g, f32x2 u, float r) {
        const f32x2 gr = g * r, ur = u * r, t = gr * (-1.4426950408889634f);
        f32x2 e; e.x = __builtin_amdgcn_exp2f(t.x); e.y = __builtin_amdgcn_exp2f(t.y);
        const f32x2 d = e + 1.0f; f32x2 q; q.x = __builtin_amdgcn_rcpf(d.x); q.y = __builtin_amdgcn_rcpf(d.y);
        const f32x2 o = (gr * ur) * q; return cvt_pk_bf16(o.x, o.y); }
    __device__ __forceinline__ void operator()(const f32x4 (&acc)[2][2][4][2], const Unit& u, int wr, int wc, int fr, int fq) const {
        const int row0 = u.pm * BM + wr * 64 + fr, col0 = u.pn * HALF + wc * 32 + 8 * fq;
#pragma unroll
        for (int ai = 0; ai < 2; ++ai)
#pragma unroll
            for (int m = 0; m < 4; ++m) { bf16_t* rowp = O + (size_t)(row0 + ai * HALF + m * 16) * ldc + col0; const float r = rs[ai * HALF + wr * 64 + m * 16 + fr];
                const f32x4 g0 = acc[ai][0][m][0], g1 = acc[ai][0][m][1], u0 = acc[ai][1][m][0], u1 = acc[ai][1][m][1];
                u32x4 w; w.x = silu_mul_pk((f32x2){g0[0], g0[1]}, (f32x2){u0[0], u0[1]}, r); w.y = silu_mul_pk((f32x2){g0[2], g0[3]}, (f32x2){u0[2], u0[3]}, r);
                w.z = silu_mul_pk((f32x2){g1[0], g1[1]}, (f32x2){u1[0], u1[1]}, r); w.w = silu_mul_pk((f32x2){g1[2], g1[3]}, (f32x2){u1[2], u1[3]}, r);
                *(u32x4*)rowp = w; }
    }
};
template <int ACT> struct EpiAct {
    static constexpr bool PERM = true, AFTER_DRAIN = false;
    bf16_t* O; int ldc; const PG8_LAS float* rs; float* partv; int pn_v0;
    __device__ __forceinline__ void operator()(const f32x4 (&acc)[2][2][4][2], const Unit& u, int wr, int wc, int fr, int fq) const {
        const int row0 = u.pm * BM + wr * 64 + fr, col0 = u.pn * BM + wc * 32 + 8 * fq;
        const bool stat = (partv != nullptr) && (u.pn >= pn_v0);
#pragma unroll
        for (int ai = 0; ai < 2; ++ai)
#pragma unroll
            for (int m = 0; m < 4; ++m) { const int row = row0 + ai * HALF + m * 16; bf16_t* rowp = O + (size_t)row * ldc + col0; const float r = rs[ai * HALF + wr * 64 + m * 16 + fr]; float s = 0.f;
#pragma unroll
                for (int bj = 0; bj < 2; ++bj) { f32x4 v0 = acc[ai][bj][m][0] * r, v1 = acc[ai][bj][m][1] * r;
                    if (ACT == 1) { f32x2 a = gelu_pk((f32x2){v0[0], v0[1]}), b = gelu_pk((f32x2){v0[2], v0[3]}), c = gelu_pk((f32x2){v1[0], v1[1]}), d = gelu_pk((f32x2){v1[2], v1[3]});
                        v0 = (f32x4){a.x, a.y, b.x, b.y}; v1 = (f32x4){c.x, c.y, d.x, d.y}; }
                    s += ((v0[0] * v0[0] + v0[1] * v0[1]) + (v0[2] * v0[2] + v0[3] * v0[3])) + ((v1[0] * v1[0] + v1[1] * v1[1]) + (v1[2] * v1[2] + v1[3] * v1[3]));
                    u32x4 w; w.x = cvt_pk_bf16(v0[0], v0[1]); w.y = cvt_pk_bf16(v0[2], v0[3]); w.z = cvt_pk_bf16(v1[0], v1[1]); w.w = cvt_pk_bf16(v1[2], v1[3]);
                    *(u32x4*)(rowp + bj * HALF) = w; }
                if (stat) { s += __shfl_xor(s, 16); s += __shfl_xor(s, 32); if (fq == 0) partv[(size_t)row * 32 + (u.pn - pn_v0) * 4 + wc] = s; } }
    }
};
}

#ifndef MK_N_LAUNCHES
#define MK_N_LAUNCHES 1
#endif

constexpr int NWAVES = 8;
constexpr int BATCH = 8, SEQ = 2048, D = 2048, FF = 5632, M = BATCH * SEQ;
constexpr float EPS = 1e-5f;
constexpr int GM_N = 4096, SWA_N = 2560, FOX_N = 6144, FOX_LD = 6160;
constexpr size_t MiB = 1u << 20;
constexpr size_t WS_CTL = 0, CTL_ZERO_BYTES = 1 * MiB;
constexpr size_t WS_W = 1 * MiB;
constexpr size_t WS_FFN_STRIDE = 66 * MiB, WS_WO_OFF = 44 * MiB;
constexpr size_t WS_MW = WS_W + 8 * WS_FFN_STRIDE;
constexpr size_t WS_XN = WS_MW + 98 * MiB;
constexpr size_t WS_BIG = WS_XN + 64 * MiB;
constexpr size_t WS_HID = WS_BIG + 192 * MiB;
constexpr size_t WS_SMALL = WS_HID + 176 * MiB;
constexpr size_t WS_END = WS_SMALL + 8 * MiB;
__host__ __device__ constexpr size_t mw_win_off(int L) { return (L == 0 ? 0 : L == 1 ? 24 : L == 2 ? 42 : 74) * MiB; }
__host__ __device__ constexpr size_t mw_wout_off(int L) { return (L == 0 ? 16 : L == 1 ? 34 : L == 2 ? 66 : 90) * MiB; }
constexpr int CW_BAR = 4096;
constexpr int RING_OFF = 0, RING_BYTES = 131072;
constexpr int LDSCTL_OFF = RING_BYTES, MISC_OFF = LDSCTL_OFF + 320;
constexpr int RS_OFF = LDSCTL_OFF + 1024;
constexpr int LDS_BYTES = 147456;

#define GAS __attribute__((address_space(1)))
#define LAS __attribute__((address_space(3)))
typedef unsigned short bf16;
typedef unsigned v4u __attribute__((ext_vector_type(4)));
typedef float f32x4 __attribute__((ext_vector_type(4)));
typedef short bf16x8 __attribute__((ext_vector_type(8)));
typedef GAS unsigned gu32;
typedef GAS unsigned long long gu64;
#define RLX_AGENT __ATOMIC_RELAXED, __HIP_MEMORY_SCOPE_AGENT
#define LDS_WAIT() asm volatile("s_waitcnt lgkmcnt(0)" ::: "memory")
#define VM_WAIT() asm volatile("s_waitcnt vmcnt(0)" ::: "memory")
__device__ __forceinline__ unsigned long long rt() { return __builtin_amdgcn_s_memrealtime(); }
__device__ __forceinline__ unsigned f2bf(float f) { unsigned u = __builtin_bit_cast(unsigned, f); return (u + 0x7fffu + ((u >> 16) & 1u)) >> 16; }
__device__ __forceinline__ unsigned pk2(float lo, float hi) { return f2bf(lo) | (f2bf(hi) << 16); }

#define XB_TMO      128
#define XB_XCNT(j)  (256  + 64 * (j))
#define XB_XSUB(j)  (1280 + 64 * (j))
#define XB_XGEN(j)  (2304 + 64 * (j))
#define XB_TOP      3328
#define XB_TOPGEN   3392
#define XCD_BAR_WORDS 3456
#define XB_SPIN_CAP (1u << 18)

__device__ __forceinline__ unsigned xb_ld(unsigned* p)              { return __hip_atomic_load(p, __ATOMIC_RELAXED, __HIP_MEMORY_SCOPE_AGENT); }
__device__ __forceinline__ unsigned xb_add(unsigned* p, unsigned v) { return __hip_atomic_fetch_add(p, v, __ATOMIC_RELAXED, __HIP_MEMORY_SCOPE_AGENT); }
__device__ __forceinline__ unsigned xb_xcc_id() { return (unsigned)__builtin_amdgcn_s_getreg((3 << 11) | 20) & 0xFu; }
#define XB_SPIN(cond, bar) do { unsigned _sp = 0; while (cond) { __builtin_amdgcn_s_sleep(1); \
    if ((++_sp & 255u) == 0u) { if (xb_ld(&(bar)[XB_TMO])) break; if (_sp > XB_SPIN_CAP) { atomicAdd(&(bar)[XB_TMO], 1u); break; } } } } while (0)

struct XcdBarrier {
    unsigned* bar; unsigned x;
    volatile LAS unsigned* st;
};

__device__ __forceinline__ XcdBarrier xcd_barrier_post(unsigned* bar, volatile LAS unsigned* st) {
    XcdBarrier b; b.bar = bar; b.x = xb_xcc_id(); b.st = st;
    if (threadIdx.x == 0) (void)xb_add(&bar[XB_XCNT(b.x)], 1u);
    return b;
}
__device__ __forceinline__ void xcd_barrier_complete(unsigned* bar, unsigned x, unsigned& nloc, unsigned& nx) {
    const unsigned G = gridDim.x * gridDim.y * gridDim.z;
    unsigned sum, cnt, mine, sp = 0u;
    for (;;) {
        sum = 0u; cnt = 0u; mine = 0u;
#pragma unroll
        for (unsigned j = 0; j < 16; ++j) { const unsigned c = xb_ld(&bar[XB_XCNT(j)]); sum += c; cnt += (c > 0u) ? 1u : 0u; mine = (j == x) ? c : mine; }
        if (sum == G) break;
        __builtin_amdgcn_s_sleep(1);
        if ((++sp & 255u) == 0u) { if (xb_ld(&bar[XB_TMO])) break; if (sp > XB_SPIN_CAP) { atomicAdd(&bar[XB_TMO], 1u); break; } }
    }
    nloc = mine > 0u ? mine : 1u; nx = cnt > 0u ? cnt : 1u;
}

__device__ __forceinline__ void xcd_barrier(const XcdBarrier& b) {
    asm volatile("s_waitcnt vmcnt(0)" ::: "memory");
    __syncthreads();
    if (threadIdx.x == 0) {
        unsigned* bar = b.bar;
        __builtin_amdgcn_s_waitcnt(0);
        unsigned nloc = b.st[0], nx = b.st[1];
        if (nloc == 0u) { xcd_barrier_complete(bar, b.x, nloc, nx); b.st[0] = nloc; b.st[1] = nx; }
        const unsigned old = xb_add(&bar[XB_XSUB(b.x)], 1u);
        const unsigned gen = old / nloc;
        if (old + 1u == (gen + 1u) * nloc) {
            __builtin_amdgcn_fence(__ATOMIC_RELEASE, "agent");
            asm volatile("s_waitcnt vmcnt(0)" ::: "memory");
            const unsigned og = xb_add(&bar[XB_TOP], 1u);
            const unsigned tg = og / nx;
            if (og + 1u == (tg + 1u) * nx) xb_add(&bar[XB_TOPGEN], 1u);
            else XB_SPIN(xb_ld(&bar[XB_TOPGEN]) == tg, bar);
            __builtin_amdgcn_fence(__ATOMIC_ACQUIRE, "agent");
            xb_add(&bar[XB_XGEN(b.x)], 1u);
            asm volatile("s_waitcnt vmcnt(0)" ::: "memory");
        } else {
            XB_SPIN(xb_ld(&bar[XB_XGEN(b.x)]) == gen, bar);
            __builtin_amdgcn_fence(__ATOMIC_ACQUIRE, "agent");
            asm volatile("s_waitcnt vmcnt(0)" ::: "memory");
        }
    }
    __syncthreads();
}

struct Args {
    const float* x;
    const float* ffn_norm[8]; const float* ffn_wi[8]; const float* ffn_wo[8];
    const float* mix_norm[4]; const float* mix_win[4]; const float* mix_wout[4];
    const float* mix_p0[4];
    const float* mix_p1[4];
    const float* mix_p2[4];
    const float* final_norm;
    float* out; unsigned char* ws; int ph_lo, ph_hi;
};
struct Frame {
    LAS unsigned char* lds;
    volatile LAS unsigned* MISC;
    gu32* ctl;
    int tid, lane, wave;
    int vcu, G;
};

__device__ __forceinline__ float wave_sum(float v) {
#pragma unroll
    for (int o = 1; o < 64; o <<= 1) v += __shfl_xor(v, o);
    return v;
}
__device__ __forceinline__ float bflo(unsigned w) { return __builtin_bit_cast(float, w << 16); }
__device__ __forceinline__ float bfhi(unsigned w) { return __builtin_bit_cast(float, w & 0xffff0000u); }
__device__ __forceinline__ void unpack8(const v4u w, float* f) {
    f[0] = bflo(w.x); f[1] = bfhi(w.x); f[2] = bflo(w.y); f[3] = bfhi(w.y); f[4] = bflo(w.z); f[5] = bfhi(w.z); f[6] = bflo(w.w); f[7] = bfhi(w.w);
}

struct P0Item { const float* W; bf16* WT; const float* gk; int ldw, Kdst, k0, n0, dr; };
constexpr int P0_WI = (D / 64) * (2 * FF / 32), P0_WO = (FF / 64) * (D / 32), P0_FFN = P0_WI + P0_WO, P0_SQ = (D / 64) * (D / 32);
constexpr int P0_GM = (D / 64) * (GM_N / 32), P0_SW = (D / 64) * (SWA_N / 32), P0_FX = (D / 64) * (FOX_N / 32);
constexpr int P0_M1 = 8 * P0_FFN + P0_GM + P0_SQ, P0_M2 = P0_M1 + P0_SW + P0_SQ, P0_M3 = P0_M2 + P0_FX + P0_SQ, P0_TOTAL = P0_M3 + P0_GM + P0_SQ;
__device__ __forceinline__ P0Item p0_decode(int g, const Args& a, unsigned char* ws) {
    P0Item it; int kb, nb; bool swi = false;
    if (g < 8 * P0_FFN) { const int s = g / P0_FFN; int r = g - s * P0_FFN;
        if (r < P0_WI) { kb = r / (2 * FF / 32); nb = r - kb * (2 * FF / 32); it.W = a.ffn_wi[s]; it.ldw = 2 * FF; it.Kdst = D; it.WT = (bf16*)(ws + WS_W + s * WS_FFN_STRIDE); it.gk = a.ffn_norm[s]; swi = true; }
        else { r -= P0_WI; kb = r / (D / 32); nb = r - kb * (D / 32); it.W = a.ffn_wo[s]; it.ldw = D; it.Kdst = FF; it.WT = (bf16*)(ws + WS_W + s * WS_FFN_STRIDE + WS_WO_OFF); it.gk = nullptr; }
    } else {
        const int L = (g < P0_M1) ? 0 : (g < P0_M2) ? 1 : (g < P0_M3) ? 2 : 3;
        int r = g - ((L == 0) ? 8 * P0_FFN : (L == 1) ? P0_M1 : (L == 2) ? P0_M2 : P0_M3);
        const int n = (L == 1) ? SWA_N : (L == 2) ? FOX_N : GM_N, nblk = n / 32, win = (D / 64) * nblk;
        if (r < win) { kb = r / nblk; nb = r - kb * nblk; it.W = a.mix_win[L]; it.ldw = (L == 2) ? FOX_LD : n; it.Kdst = D; it.WT = (bf16*)(ws + WS_MW + mw_win_off(L)); it.gk = a.mix_norm[L]; }
        else { r -= win; kb = r / (D / 32); nb = r - kb * (D / 32); it.W = a.mix_wout[L]; it.ldw = D; it.Kdst = D; it.WT = (bf16*)(ws + WS_MW + mw_wout_off(L)); it.gk = nullptr; }
    }
    it.k0 = 64 * kb; it.n0 = 32 * nb; it.dr = it.n0;
    if (swi) { const int up = it.n0 >= FF ? 1 : 0, c = it.n0 - up * FF; it.dr = (c >> 7) * 256 + up * 128 + (c & 127); }
    return it;
}
__device__ __forceinline__ void p0_load(float (&r)[32], const P0Item& it, int lane) {
    const GAS char* base = (const GAS char*)it.W + ((size_t)it.k0 * it.ldw + it.n0) * 4;
    const unsigned off = (unsigned)((lane >> 5) * it.ldw + (lane & 31)) * 4u, step = (unsigned)it.ldw * 8u;
#pragma unroll
    for (int i = 0; i < 32; ++i) r[i] = *(const GAS float*)(base + (off + (unsigned)i * step));
}
__device__ __forceinline__ void p0_weights(Frame& F, const Args& a) {
    unsigned char* ws = a.ws; LAS float* scr = (LAS float*)(F.lds + RING_OFF + F.wave * 16384);
    const int NGW = F.G * NWAVES; int g = F.vcu * NWAVES + F.wave; const int lane = F.lane, c = lane & 7;
    if (g >= P0_TOTAL) return;
    float r[32]; P0Item cur = p0_decode(g, a, ws); p0_load(r, cur, lane);
    while (true) {
        f32x4 ga = (f32x4){1.f, 1.f, 1.f, 1.f}, gb = ga;
        if (cur.gk) { ga = *(const GAS f32x4*)(cur.gk + cur.k0 + 8 * c); gb = *(const GAS f32x4*)(cur.gk + cur.k0 + 8 * c + 4); }
#pragma unroll
        for (int i = 0; i < 32; ++i) scr[(2 * i + (lane >> 5)) * 33 + (lane & 31)] = r[i];
        asm volatile("" ::: "memory");
        const int gn = g + NGW; const bool more = gn < P0_TOTAL; P0Item nx = cur;
        if (more) { nx = p0_decode(gn, a, ws); p0_load(r, nx, lane); }
        LDS_WAIT(); asm volatile("" ::: "memory");
#pragma unroll
        for (int j = 0; j < 4; ++j) { const int n = (lane >> 3) + 8 * j; const LAS float* s = scr + (8 * c) * 33 + n;
            v4u o; o.x = pk2(s[0 * 33] * ga.x, s[1 * 33] * ga.y); o.y = pk2(s[2 * 33] * ga.z, s[3 * 33] * ga.w); o.z = pk2(s[4 * 33] * gb.x, s[5 * 33] * gb.y); o.w = pk2(s[6 * 33] * gb.z, s[7 * 33] * gb.w);
            *(GAS v4u*)(cur.WT + ((size_t)((cur.dr >> 8) * (cur.Kdst >> 6) + (cur.k0 >> 6)) * 256 + (cur.dr & 255) + n) * 64 + 8 * c) = o; }
        LDS_WAIT(); asm volatile("" ::: "memory");
        if (!more) break;
        cur = nx; g = gn;
    }
}
__device__ __forceinline__ void p0_prologue(Frame& F, const Args& a) {
    unsigned char* ws = a.ws;
    p0_weights(F, a);
    { bf16* wft = (bf16*)(ws + WS_SMALL + 7 * MiB); const float* w = a.mix_win[2]; const float* g = a.mix_norm[2];
      for (int i = F.vcu * 512 + F.tid; i < D * 16; i += F.G * 512) { const int k = i >> 4, n = i & 15; wft[n * D + k] = (bf16)f2bf(w[(size_t)k * FOX_LD + FOX_N + n] * g[k]); } }
    { const int gw = F.vcu * NWAVES + F.wave, NGW = F.G * NWAVES; bf16* hb = (bf16*)(ws + WS_XN); float* part = (float*)(ws + WS_SMALL + 3 * MiB);
      for (int m = gw; m < M; m += NGW) {
          const GAS f32x4* xr = (const GAS f32x4*)(a.x + (size_t)m * D) + F.lane; f32x4 v[8]; float s = 0.f;
#pragma unroll
          for (int j = 0; j < 8; ++j) { v[j] = xr[64 * j]; s += (v[j].x * v[j].x + v[j].y * v[j].y) + (v[j].z * v[j].z + v[j].w * v[j].w); }
          s = wave_sum(s);
          GAS unsigned long long* o8 = (GAS unsigned long long*)(hb + (size_t)m * D) + F.lane;
#pragma unroll
          for (int j = 0; j < 8; ++j) o8[64 * j] = (unsigned long long)pk2(v[j].x, v[j].y) | ((unsigned long long)pk2(v[j].z, v[j].w) << 32);
          if (F.lane < 32) part[(size_t)m * 32 + F.lane] = (F.lane == 0) ? s : 0.f; } }
    { float* rope = (float*)(ws + WS_SMALL + 2 * MiB);
      for (int i = F.vcu * 512 + F.tid; i < SEQ * 8; i += F.G * 512) { const int s = i >> 3, j = i & 7;
          const float invf = exp2f(-(float)j * 0.125f * 18.931568569324174f);
          const float ang = (float)s * invf; double r = (double)ang * 0.15915494309189535; r -= rint(r); const float rf = (float)r;
          rope[s * 16 + j] = __builtin_amdgcn_cosf(rf); rope[s * 16 + 8 + j] = __builtin_amdgcn_sinf(rf); } }
}
__device__ __forceinline__ int wg_panel() { const int c = blockIdx.x; return 8 * (c & 7) + ((c >> 3) & 7); }
__device__ __forceinline__ void panel_rstd(Frame& F, const float* part) {
    LAS float* RS = (LAS float*)(F.lds + RS_OFF);
    if (F.tid < 256) { const GAS f32x4* p = (const GAS f32x4*)(part + (size_t)(wg_panel() * 256 + F.tid) * 32); float s = 0.f;
#pragma unroll
        for (int q = 0; q < 8; ++q) { const f32x4 v = p[q]; s += (v.x + v.y) + (v.z + v.w); }
        RS[F.tid] = 1.f / sqrtf(s * (1.f / D) + EPS); }
    __syncthreads();
}
__device__ __forceinline__ void fox_fl(Frame& F, const bf16* HB, const bf16* WfT, const float* bfp, float* lgf) {
    const LAS float* RS = (const LAS float*)(F.lds + RS_OFF);
    if (F.wave < 4) {
        const int r = F.lane & 15, kq = F.lane >> 4, rl = ((int)blockIdx.x >> 6) * 64 + F.wave * 16, row0 = wg_panel() * 256;
        const bf16* ap = HB + (size_t)(row0 + rl + r) * D + 8 * kq; const bf16* bp = WfT + (size_t)r * D + 8 * kq;
        f32x4 acc = (f32x4){0.f, 0.f, 0.f, 0.f};
#pragma unroll 8
        for (int ks = 0; ks < 64; ++ks) acc = __builtin_amdgcn_mfma_f32_16x16x32_bf16(*(const GAS bf16x8*)(ap + 32 * ks), *(const GAS bf16x8*)(bp + 32 * ks), acc, 0, 0, 0);
        const float bb = bfp[r];
#pragma unroll
        for (int i = 0; i < 4; ++i) { const int rr = rl + 4 * kq + i; const float xx = acc[i] * RS[rr] + bb; lgf[(size_t)(row0 + rr) * 16 + r] = fminf(xx, 0.f) - log1pf(expf(-fabsf(xx))); }
    }
}

template <int FOX> __device__ __forceinline__ void rms_phase(Frame& F, const float* h, const float* g, bf16* xn, const float* wf, const float* bfp, float* lgf) {
    const int gw = F.vcu * NWAVES + F.wave, NGW = F.G * NWAVES;
    LAS float* WL = (LAS float*)(F.lds + RING_OFF);
    if (FOX) {
        for (int i = F.tid; i < 2048 * 16; i += 512) { const int k = i >> 4, c = i & 15; WL[c * 2048 + k] = wf[(size_t)k * FOX_LD + FOX_N + c]; }
        __syncthreads();
    }
    f32x4 gv[8];
#pragma unroll
    for (int j = 0; j < 8; ++j) gv[j] = ((const GAS f32x4*)g)[F.lane + 64 * j];
    for (int m = gw; m < M; m += NGW) {
        const GAS f32x4* xr = (const GAS f32x4*)(h + (size_t)m * D) + F.lane;
        f32x4 v[8]; float s = 0.f;
#pragma unroll
        for (int j = 0; j < 8; ++j) { v[j] = xr[64 * j]; s += (v[j].x * v[j].x + v[j].y * v[j].y) + (v[j].z * v[j].z + v[j].w * v[j].w); }
        const float rstd = 1.f / sqrtf(wave_sum(s) * (1.f / D) + EPS);
        GAS unsigned long long* o8 = (GAS unsigned long long*)(xn + (size_t)m * D) + F.lane;
#pragma unroll
        for (int j = 0; j < 8; ++j) { v[j] = v[j] * rstd * gv[j]; o8[64 * j] = (unsigned long long)pk2(v[j].x, v[j].y) | ((unsigned long long)pk2(v[j].z, v[j].w) << 32); }
        if (FOX) {
            float mine = 0.f;
#pragma unroll 1
            for (int c = 0; c < 16; ++c) { float a = 0.f;
#pragma unroll
                for (int j = 0; j < 8; ++j) { const f32x4 w = *(const LAS f32x4*)(WL + c * 2048 + 4 * (F.lane + 64 * j)); a += (v[j].x * w.x + v[j].y * w.y) + (v[j].z * w.z + v[j].w * w.w); }
                a = wave_sum(a); mine = (F.lane == c) ? a : mine; }
            if (F.lane < 16) { const float xx = mine + bfp[F.lane]; lgf[(size_t)m * 16 + F.lane] = fminf(xx, 0.f) - log1pf(expf(-fabsf(xx))); }
        }
    }
    if (FOX) __syncthreads();
}
__device__ __forceinline__ void final_norm_phase(Frame& F, const bf16* hb, float* out, const float* g) {
    const int gw = F.vcu * NWAVES + F.wave, NGW = F.G * NWAVES;
    f32x4 ga[4], gb[4];
#pragma unroll
    for (int j = 0; j < 4; ++j) { ga[j] = ((const GAS f32x4*)g)[2 * (F.lane + 64 * j)]; gb[j] = ((const GAS f32x4*)g)[2 * (F.lane + 64 * j) + 1]; }
    for (int m = gw; m < M; m += NGW) {
        const GAS v4u* xr = (const GAS v4u*)(hb + (size_t)m * D) + F.lane;
        float v[4][8]; float s = 0.f;
#pragma unroll
        for (int j = 0; j < 4; ++j) { unpack8(xr[64 * j], v[j]);
#pragma unroll
            for (int k = 0; k < 8; ++k) s += v[j][k] * v[j][k]; }
        const float rstd = 1.f / sqrtf(wave_sum(s) * (1.f / D) + EPS);
        GAS f32x4* o = (GAS f32x4*)(out + (size_t)m * D);
#pragma unroll
        for (int j = 0; j < 4; ++j) { o[2 * (F.lane + 64 * j)] = (f32x4){v[j][0], v[j][1], v[j][2], v[j][3]} * rstd * ga[j]; o[2 * (F.lane + 64 * j) + 1] = (f32x4){v[j][4], v[j][5], v[j][6], v[j][7]} * rstd * gb[j]; }
    }
}
__device__ __forceinline__ void silu_phase(Frame& F, const bf16* big, bf16* hid) {
    const size_t nv = (size_t)M * (FF / 8);
    for (size_t i = (size_t)F.vcu * 512 + F.tid; i < nv; i += (size_t)F.G * 512) {
        const size_t m = i / (FF / 8); const int j8 = (int)(i - m * (FF / 8));
        const v4u gw4 = *(const GAS v4u*)(big + m * (2 * FF) + 8 * j8), uw4 = *(const GAS v4u*)(big + m * (2 * FF) + FF + 8 * j8);
        float gf[8], uf[8], r[8]; unpack8(gw4, gf); unpack8(uw4, uf);
#pragma unroll
        for (int k = 0; k < 8; ++k) r[k] = gf[k] / (1.f + __expf(-gf[k])) * uf[k];
        v4u o; o.x = pk2(r[0], r[1]); o.y = pk2(r[2], r[3]); o.z = pk2(r[4], r[5]); o.w = pk2(r[6], r[7]);
        *(GAS v4u*)(hid + m * FF + 8 * j8) = o;
    }
}
__device__ __forceinline__ void gmlp_vstat_phase(Frame& F, const bf16* z, float* vstat) {
    const int gw = F.vcu * NWAVES + F.wave, NGW = F.G * NWAVES;
    for (int m = gw; m < M; m += NGW) {
        const GAS v4u* p = (const GAS v4u*)(z + (size_t)m * GM_N + 2048) + F.lane; float s = 0.f;
#pragma unroll
        for (int j = 0; j < 4; ++j) { float f[8]; unpack8(p[64 * j], f);
#pragma unroll
            for (int k = 0; k < 8; ++k) s += f[k] * f[k]; }
        s = wave_sum(s);
        if (F.lane == 0) vstat[m] = 1.f / sqrtf(s * (1.f / 2048.f) + EPS);
    }
}
__device__ __forceinline__ void gmlp_spatial_naive(Frame& F, const bf16* z, const float* vstat, const float* vg, const float* wsp, const float* bsp, bf16* y) {
    LAS float* WsT = (LAS float*)(F.lds + RING_OFF);
    LAS float* V = (LAS float*)(F.lds + RING_OFF + 65536);
    const int tt = F.tid >> 4, ww = F.tid & 15;
    for (int unit = F.vcu; unit < 2048; unit += F.G) {
        const int g = unit & 15, r0 = (unit >> 4) * 128;
        __syncthreads();
        for (int i = F.tid; i < 16384; i += 512) { const int t = i >> 7, s = i & 127; WsT[s * 128 + t] = (s <= t) ? wsp[(size_t)g * 16384 + i] : 0.f; }
        for (int i = F.tid; i < 16384; i += 512) { const int s = i >> 7, w = i & 127;
            const unsigned short b = z[(size_t)(r0 + s) * GM_N + 2048 + g * 128 + w];
            V[i] = __builtin_bit_cast(float, ((unsigned)b) << 16) * vstat[r0 + s] * vg[g * 128 + w]; }
        __syncthreads();
        float acc[4][8];
#pragma unroll
        for (int i = 0; i < 4; ++i)
#pragma unroll
            for (int j = 0; j < 8; ++j) acc[i][j] = 0.f;
        for (int s = 0; s < 128; ++s) {
            const f32x4 a = *(const LAS f32x4*)(WsT + s * 128 + tt * 4);
            const f32x4 v0 = *(const LAS f32x4*)(V + s * 128 + ww * 8), v1 = *(const LAS f32x4*)(V + s * 128 + ww * 8 + 4);
#pragma unroll
            for (int i = 0; i < 4; ++i) {
#pragma unroll
                for (int j = 0; j < 4; ++j) { acc[i][j] += a[i] * v0[j]; acc[i][4 + j] += a[i] * v1[j]; } }
        }
#pragma unroll
        for (int i = 0; i < 4; ++i) { const int t = tt * 4 + i; const size_t row = (size_t)(r0 + t); const float bias = bsp[g * 128 + t];
            float uf[8]; unpack8(*(const GAS v4u*)(z + row * GM_N + g * 128 + ww * 8), uf);
            v4u o; o.x = pk2(uf[0] * (acc[i][0] + bias), uf[1] * (acc[i][1] + bias)); o.y = pk2(uf[2] * (acc[i][2] + bias), uf[3] * (acc[i][3] + bias));
            o.z = pk2(uf[4] * (acc[i][4] + bias), uf[5] * (acc[i][5] + bias)); o.w = pk2(uf[6] * (acc[i][6] + bias), uf[7] * (acc[i][7] + bias));
            *(GAS v4u*)(y + row * D + g * 128 + ww * 8) = o; }
    }
    __syncthreads();
}
__device__ __forceinline__ void swa_naive(Frame& F, const bf16* qkv, const float* sinks, const float* rope, bf16* o) {
    const int gw = F.vcu * NWAVES + F.wave, NGW = F.G * NWAVES;
    for (int u = gw; u < 8192; u += NGW) {
        const int qb = u & 31, hq = (u >> 5) & 31, b = u >> 10, kv = hq >> 3;
        const int t = qb * 64 + F.lane; const size_t m = (size_t)b * SEQ + t;
        float q[64];
        { const GAS v4u* qp = (const GAS v4u*)(qkv + m * SWA_N + hq * 64);
#pragma unroll
          for (int i = 0; i < 8; ++i) unpack8(qp[i], q + 8 * i);
          const float* rp = rope + t * 16;
#pragma unroll
          for (int i = 0; i < 8; ++i) { const float c = rp[i], s = rp[8 + i], x1 = q[i], x2 = q[8 + i]; q[i] = x1 * c - x2 * s; q[8 + i] = x2 * c + x1 * s; }
#pragma unroll
          for (int i = 0; i < 64; ++i) q[i] *= 0.125f; }
        float acc[64];
#pragma unroll
        for (int i = 0; i < 64; ++i) acc[i] = 0.f;
        float mrun = sinks[hq], l = 1.f;
        const int s0 = (qb * 64 - 127) > 0 ? (qb * 64 - 127) : 0, s1 = qb * 64 + 63;
        for (int s = s0; s <= s1; ++s) {
            const size_t mk = (size_t)b * SEQ + s;
            const GAS v4u* kp = (const GAS v4u*)(qkv + mk * SWA_N + 2048 + kv * 64);
            float dot = 0.f;
            { float k0[16]; unpack8(kp[0], k0); unpack8(kp[1], k0 + 8);
              const float* rk = rope + s * 16;
#pragma unroll
              for (int i = 0; i < 8; ++i) { const float c = rk[i], sn = rk[8 + i], x1 = k0[i], x2 = k0[8 + i]; dot += q[i] * (x1 * c - x2 * sn) + q[8 + i] * (x2 * c + x1 * sn); } }
#pragma unroll
            for (int i = 2; i < 8; ++i) { float kf[8]; unpack8(kp[i], kf);
#pragma unroll
                for (int k = 0; k < 8; ++k) dot += q[8 * i + k] * kf[k]; }
            const bool valid = (s <= t) && (t - s < 128);
            if (valid) {
                if (dot > mrun) { const float corr = __expf(mrun - dot); l *= corr;
#pragma unroll
                    for (int i = 0; i < 64; ++i) acc[i] *= corr;
                    mrun = dot; }
                const float p = __expf(dot - mrun); l += p;
                const GAS v4u* vp = (const GAS v4u*)(qkv + mk * SWA_N + 2304 + kv * 64);
#pragma unroll
                for (int i = 0; i < 8; ++i) { float vf[8]; unpack8(vp[i], vf);
#pragma unroll
                    for (int k = 0; k < 8; ++k) acc[8 * i + k] += p * vf[k]; }
            }
        }
        const float inv = 1.f / l;
        GAS v4u* op = (GAS v4u*)(o + m * D + hq * 64);
#pragma unroll
        for (int i = 0; i < 8; ++i) { v4u w; w.x = pk2(acc[8 * i] * inv, acc[8 * i + 1] * inv); w.y = pk2(acc[8 * i + 2] * inv, acc[8 * i + 3] * inv);
            w.z = pk2(acc[8 * i + 4] * inv, acc[8 * i + 5] * inv); w.w = pk2(acc[8 * i + 6] * inv, acc[8 * i + 7] * inv); op[i] = w; }
    }
}
__device__ __forceinline__ void fox_cumsum_phase(Frame& F, float* dec) {
    const int gw = F.vcu * NWAVES + F.wave, NGW = F.G * NWAVES;
    for (int p = gw; p < BATCH * 16; p += NGW) {
        const int b = p >> 4, hh = p & 15;
        float* base = dec + ((size_t)b * SEQ + 32 * F.lane) * 16 + hh;
        float v[32]; float run = 0.f;
#pragma unroll
        for (int i = 0; i < 32; ++i) { run += base[i * 16]; v[i] = run; }
        float incl = run;
#pragma unroll
        for (int o = 1; o < 64; o <<= 1) { const float t = __shfl_up(incl, o); if (F.lane >= o) incl += t; }
        const float excl = incl - run;
#pragma unroll
        for (int i = 0; i < 32; ++i) base[i * 16] = (v[i] + excl) * 1.4426950408889634f;
    }
}
__device__ __forceinline__ void fox_naive(Frame& F, const bf16* qkv, const float* dec, bf16* o) {
    const int gw = F.vcu * NWAVES + F.wave, NGW = F.G * NWAVES;
    const int qi = F.lane & 31, half = F.lane >> 5;
    for (int u = gw; u < 8192; u += NGW) {
        const int b = u >> 10, hh = (u >> 6) & 15; int qb = u & 63; if ((b >> 1) & 1) qb = 63 - qb;
        const int t = qb * 32 + qi; const size_t m = (size_t)b * SEQ + t;
        float q[64];
        { const GAS v4u* qp = (const GAS v4u*)(qkv + m * FOX_N + hh * 128 + half * 64);
#pragma unroll
          for (int i = 0; i < 8; ++i) unpack8(qp[i], q + 8 * i);
#pragma unroll
          for (int i = 0; i < 64; ++i) q[i] *= 0.08838834764831845f; }
        const float Dt = dec[m * 16 + hh];
        float acc[64];
#pragma unroll
        for (int i = 0; i < 64; ++i) acc[i] = 0.f;
        float mrun = -1e30f, l = 0.f;
        const int s1 = qb * 32 + 31;
        for (int s = 0; s <= s1; ++s) {
            const size_t mk = (size_t)b * SEQ + s;
            const GAS v4u* kp = (const GAS v4u*)(qkv + mk * FOX_N + 2048 + hh * 128 + half * 64);
            float dot = 0.f;
#pragma unroll
            for (int i = 0; i < 8; ++i) { float kf[8]; unpack8(kp[i], kf);
#pragma unroll
                for (int k = 0; k < 8; ++k) dot += q[8 * i + k] * kf[k]; }
            dot += __shfl_xor(dot, 32);
            const float sc = dot + (Dt - dec[mk * 16 + hh]);
            if (s <= t) {
                if (sc > mrun) { const float corr = __expf(mrun - sc); l *= corr;
#pragma unroll
                    for (int i = 0; i < 64; ++i) acc[i] *= corr;
                    mrun = sc; }
                const float p = __expf(sc - mrun); l += p;
                const GAS v4u* vp = (const GAS v4u*)(qkv + mk * FOX_N + 4096 + hh * 128 + half * 64);
#pragma unroll
                for (int i = 0; i < 8; ++i) { float vf[8]; unpack8(vp[i], vf);
#pragma unroll
                    for (int k = 0; k < 8; ++k) acc[8 * i + k] += p * vf[k]; }
            }
        }
        const float inv = 1.f / l;
        GAS v4u* op = (GAS v4u*)(o + m * D + hh * 128 + half * 64);
#pragma unroll
        for (int i = 0; i < 8; ++i) { v4u w; w.x = pk2(acc[8 * i] * inv, acc[8 * i + 1] * inv); w.y = pk2(acc[8 * i + 2] * inv, acc[8 * i + 3] * inv);
            w.z = pk2(acc[8 * i + 4] * inv, acc[8 * i + 5] * inv); w.w = pk2(acc[8 * i + 6] * inv, acc[8 * i + 7] * inv); op[i] = w; }
    }
}

typedef float f32x16 __attribute__((ext_vector_type(16)));
typedef short s16x4 __attribute__((ext_vector_type(4)));
typedef short v4i16_t __attribute__((ext_vector_type(4)));
typedef float f32x2_t __attribute__((ext_vector_type(2))); typedef __bf16 bf16x2_t __attribute__((ext_vector_type(2)));
__device__ __forceinline__ unsigned cvtpk_s(float lo, float hi) { f32x2_t v = {lo, hi}; bf16x2_t r = __builtin_convertvector(v, bf16x2_t); return __builtin_bit_cast(unsigned, r); }
__device__ __forceinline__ s16x4 vtr(const LAS unsigned char* p) { return __builtin_bit_cast(s16x4, __builtin_amdgcn_ds_read_tr16_b64_v4i16((LAS v4i16_t*)p)); }
__device__ __forceinline__ float xhalf_max(float m) { float a = m, b = m; asm volatile("s_nop 1\n\tv_permlane32_swap_b32 %0, %1\n\ts_nop 1" : "+v"(a), "+v"(b)); return fmaxf(a, b); }
__device__ __forceinline__ float xhalf_sum(float m) { float a = m, b = m; asm volatile("s_nop 1\n\tv_permlane32_swap_b32 %0, %1\n\ts_nop 1" : "+v"(a), "+v"(b)); return a + b; }
__device__ __forceinline__ bf16x8 pack8(const f32x16& x, int s) {
    v4u p; p.x = cvtpk_s(x[8 * s], x[8 * s + 1]); p.y = cvtpk_s(x[8 * s + 2], x[8 * s + 3]); p.z = cvtpk_s(x[8 * s + 4], x[8 * s + 5]); p.w = cvtpk_s(x[8 * s + 6], x[8 * s + 7]);
    return __builtin_bit_cast(bf16x8, p); }
constexpr int FK_STR = 272, FV_STR = 320, FK_BYTES = 64 * FK_STR, FV_BYTES = 64 * FV_STR;
constexpr int FX_K0 = 0, FX_V0 = 2 * FK_BYTES, FX_D0 = FX_V0 + 3 * FV_BYTES;
static_assert(FX_D0 + 8192 + 64 <= RING_BYTES, "fox attention LDS");
__device__ __forceinline__ void fox_stage_a(f32x16& s0, f32x16& s1, const bf16x8 (&qf)[8], const LAS unsigned char* Kb, const LAS float* Db, bool diag, int qpos, int kb0) {
#pragma unroll
    for (int r = 0; r < 16; ++r) { s0[r] = 0.f; s1[r] = 0.f; }
#pragma unroll
    for (int ks = 0; ks < 8; ++ks) {
        const bf16x8 a0 = *(const LAS bf16x8*)(Kb + 32 * ks), a1 = *(const LAS bf16x8*)(Kb + 32 * FK_STR + 32 * ks);
        s0 = __builtin_amdgcn_mfma_f32_32x32x16_bf16(a0, qf[ks], s0, 0, 0, 0);
        s1 = __builtin_amdgcn_mfma_f32_32x32x16_bf16(a1, qf[ks], s1, 0, 0, 0); }
#pragma unroll
    for (int g = 0; g < 4; ++g) { const f32x4 d0 = *(const LAS f32x4*)(Db + 8 * g), d1 = *(const LAS f32x4*)(Db + 32 + 8 * g);
#pragma unroll
        for (int i = 0; i < 4; ++i) { s0[4 * g + i] = s0[4 * g + i] * 0.12751743074602467f - d0[i]; s1[4 * g + i] = s1[4 * g + i] * 0.12751743074602467f - d1[i]; } }
    if (diag) {
#pragma unroll
        for (int r = 0; r < 16; ++r) { const int kv = kb0 + (r & 3) + 8 * (r >> 2); if (kv > qpos) s0[r] = -INFINITY; if (kv + 32 > qpos) s1[r] = -INFINITY; }
    }
}
__device__ __forceinline__ void fox_stage_b(f32x16& s0, f32x16& s1, f32x16 (&O)[4], float& m, float& l, const LAS unsigned char* Vb) {
    float mt = fmaxf(s0[0], s1[0]);
#pragma unroll
    for (int r = 1; r < 16; ++r) mt = fmaxf(mt, fmaxf(s0[r], s1[r]));
    mt = xhalf_max(mt);
    const float mn = fmaxf(m, mt), alpha = __builtin_amdgcn_exp2f(m - mn); m = mn;
    float rs = 0.f;
#pragma unroll
    for (int r = 0; r < 16; ++r) { s0[r] = __builtin_amdgcn_exp2f(s0[r] - mn); s1[r] = __builtin_amdgcn_exp2f(s1[r] - mn); rs += s0[r] + s1[r]; }
    l = l * alpha + rs;
    if (!__all(alpha == 1.0f)) {
#pragma unroll
        for (int i = 0; i < 4; ++i)
#pragma unroll
            for (int r = 0; r < 16; ++r) O[i][r] *= alpha; }
    const bf16x8 p00 = pack8(s0, 0), p01 = pack8(s0, 1), p10 = pack8(s1, 0), p11 = pack8(s1, 1);
#pragma unroll
    for (int db = 0; db < 4; ++db) {
#define FOX_VT(kb_, s_) ({ const s16x4 lo_ = vtr(Vb + (32 * (kb_) + 16 * (s_)) * FV_STR + 64 * db), hi_ = vtr(Vb + (32 * (kb_) + 16 * (s_) + 8) * FV_STR + 64 * db); \
                   (bf16x8){lo_[0], lo_[1], lo_[2], lo_[3], hi_[0], hi_[1], hi_[2], hi_[3]}; })
        O[db] = __builtin_amdgcn_mfma_f32_32x32x16_bf16(FOX_VT(0, 0), p00, O[db], 0, 0, 0);
        O[db] = __builtin_amdgcn_mfma_f32_32x32x16_bf16(FOX_VT(0, 1), p01, O[db], 0, 0, 0);
        O[db] = __builtin_amdgcn_mfma_f32_32x32x16_bf16(FOX_VT(1, 0), p10, O[db], 0, 0, 0);
        O[db] = __builtin_amdgcn_mfma_f32_32x32x16_bf16(FOX_VT(1, 1), p11, O[db], 0, 0, 0);
#undef FOX_VT
    }
}
__device__ __forceinline__ void fox_unit(Frame& F, const bf16* qkv, bf16* o, int b, int hh, int qblk) {
    const int lane = F.lane, w = F.wave, c = lane & 31, h = lane >> 5;
    LAS unsigned char* L = F.lds + RING_OFF;
    const int q0 = qblk * 256 + 32 * w;
    const size_t mq = (size_t)b * SEQ + q0 + c;
    bf16x8 qf[8];
#pragma unroll
    for (int ks = 0; ks < 8; ++ks) qf[ks] = *(const GAS bf16x8*)(qkv + mq * FOX_N + hh * 128 + 16 * ks + 8 * h);
    f32x16 O[4];
#pragma unroll
    for (int i = 0; i < 4; ++i)
#pragma unroll
        for (int r = 0; r < 16; ++r) O[i][r] = 0.f;
    float m = -1e30f, l = 0.f;
    const int ntiles = 4 * (qblk + 1);
    const int srow = F.tid >> 3, sch = F.tid & 7;
    const bf16* kg = qkv + ((size_t)b * SEQ + srow) * FOX_N + 2048 + hh * 128 + sch * 8;
    kg += (size_t)(ntiles - 1) * 64 * FOX_N;
    v4u k0 = *(const GAS v4u*)kg, k1 = *(const GAS v4u*)(kg + 64), v0 = *(const GAS v4u*)(kg + 2048), v1 = *(const GAS v4u*)(kg + 2048 + 64);
    __syncthreads();
    *(LAS v4u*)(L + FX_K0 + srow * FK_STR + sch * 16) = k0; *(LAS v4u*)(L + FX_K0 + srow * FK_STR + sch * 16 + 128) = k1;
    *(LAS v4u*)(L + FX_V0 + srow * FV_STR + sch * 16) = v0; *(LAS v4u*)(L + FX_V0 + srow * FV_STR + sch * 16 + 128) = v1;
    __syncthreads();
    const int g16 = (lane >> 4) & 1, i16 = lane & 15, tq = i16 >> 2, tp = i16 & 3;
    const int vlane = (4 * h + tq) * FV_STR + (16 * g16 + 4 * tp) * 2;
    const int klane = c * FK_STR + 16 * h;
    const bool late = (w >= 4);
    f32x16 s0, s1; bool pend = false; int vcur = 0, vprev = 0;
    for (int jj = 0; jj < ntiles; ++jj) {
        const int j = ntiles - 1 - jj, cur = jj & 1; const bool more = (jj + 1) < ntiles;
        if (more) { kg -= (size_t)64 * FOX_N;
            k0 = *(const GAS v4u*)kg; k1 = *(const GAS v4u*)(kg + 64); v0 = *(const GAS v4u*)(kg + 2048); v1 = *(const GAS v4u*)(kg + 2048 + 64); }
        if (late && pend) { fox_stage_b(s0, s1, O, m, l, L + FX_V0 + vprev * FV_BYTES + vlane); pend = false; }
        if (64 * j <= q0 + 31) {
            fox_stage_a(s0, s1, qf, L + FX_K0 + cur * FK_BYTES + klane, (const LAS float*)(L + FX_D0) + 64 * j + 4 * h, 64 * j + 63 > q0, q0 + c, 64 * j + 4 * h);
            if (late) pend = true; else fox_stage_b(s0, s1, O, m, l, L + FX_V0 + vcur * FV_BYTES + vlane);
        }
        const int vnext = (vcur == 2) ? 0 : vcur + 1;
        if (more) { const int nx = cur ^ 1;
            *(LAS v4u*)(L + FX_K0 + nx * FK_BYTES + srow * FK_STR + sch * 16) = k0; *(LAS v4u*)(L + FX_K0 + nx * FK_BYTES + srow * FK_STR + sch * 16 + 128) = k1;
            *(LAS v4u*)(L + FX_V0 + vnext * FV_BYTES + srow * FV_STR + sch * 16) = v0; *(LAS v4u*)(L + FX_V0 + vnext * FV_BYTES + srow * FV_STR + sch * 16 + 128) = v1;
        }
        vprev = vcur; vcur = vnext;
        __syncthreads();
    }
    if (late && pend) fox_stage_b(s0, s1, O, m, l, L + FX_V0 + vprev * FV_BYTES + vlane);
    const float inv = 1.0f / xhalf_sum(l);
    bf16* op = o + mq * D + hh * 128 + 4 * h;
#pragma unroll
    for (int db = 0; db < 4; ++db)
#pragma unroll
        for (int g = 0; g < 4; ++g) { unsigned long long v = (unsigned long long)cvtpk_s(O[db][4 * g] * inv, O[db][4 * g + 1] * inv) | ((unsigned long long)cvtpk_s(O[db][4 * g + 2] * inv, O[db][4 * g + 3] * inv) << 32);
            *(GAS unsigned long long*)(op + 32 * db + 8 * g) = v; }
}
__device__ __forceinline__ void fox_attn_phase(Frame& F, const bf16* qkv, const float* lgf, bf16* o) {
    LAS unsigned char* L = F.lds + RING_OFF;
    for (int su = F.vcu; su < 256; su += F.G) {
        const int bh = su >> 1, set = su & 1, b = bh >> 4, hh = bh & 15;
        { LAS float* DL = (LAS float*)(L + FX_D0); LAS float* WT = DL + 2048;
          const float* src = lgf + ((size_t)b * SEQ + 4 * F.tid) * 16 + hh;
          const float p1 = src[0], p2 = p1 + src[16], p3 = p2 + src[32], p4 = p3 + src[48];
          float incl = p4;
#pragma unroll
          for (int ofs = 1; ofs < 64; ofs <<= 1) { const float t = __shfl_up(incl, ofs); if (F.lane >= ofs) incl += t; }
          __syncthreads();
          if (F.lane == 63) WT[F.wave] = incl;
          __syncthreads();
          float base = 0.f;
#pragma unroll
          for (int w = 0; w < NWAVES; ++w) base += (w < F.wave) ? WT[w] : 0.f;
          const float ex = base + incl - p4;
          *(LAS f32x4*)(DL + 4 * F.tid) = (f32x4){ex + p1, ex + p2, ex + p3, ex + p4} * 1.4426950408889634f;
          __syncthreads(); }
#pragma unroll 1
        for (int qi = 0; qi < 4; ++qi) { const int qblk = set ? (qi == 0 ? 6 : qi == 1 ? 5 : qi == 2 ? 2 : 1) : (qi == 0 ? 7 : qi == 1 ? 4 : qi == 2 ? 3 : 0);
            fox_unit(F, qkv, o, b, hh, qblk); }
    }
    __syncthreads();
}

constexpr int SK_STR = 144, SV_STR = 192, SX_V0 = 256 * SK_STR;
static_assert(SX_V0 + 256 * SV_STR <= RING_BYTES, "swa attention LDS");
__device__ __forceinline__ void swa_unit(Frame& F, const bf16* qkv, const float* sinks, const float* rope, bf16* o, int b, int kv, int blk) {
    const int lane = F.lane, w = F.wave, c = lane & 31, h = lane >> 5;
    LAS unsigned char* L = F.lds + RING_OFF;
    {
        const int row = F.tid >> 1, hf = F.tid & 1, kpos = (blk - 1) * 128 + row;
        v4u kk[4], vv[4];
#pragma unroll
        for (int i = 0; i < 4; ++i) { kk[i] = (v4u){0u, 0u, 0u, 0u}; vv[i] = (v4u){0u, 0u, 0u, 0u}; }
        if (kpos >= 0) {
            const bf16* kp = qkv + ((size_t)b * SEQ + kpos) * SWA_N + 2048 + kv * 64 + hf * 32;
#pragma unroll
            for (int i = 0; i < 4; ++i) { kk[i] = *(const GAS v4u*)(kp + 8 * i); vv[i] = *(const GAS v4u*)(kp + 256 + 8 * i); }
            if (hf == 0) { float x1[8], x2[8]; unpack8(kk[0], x1); unpack8(kk[1], x2); const float* rp = rope + kpos * 16; float y1[8], y2[8];
#pragma unroll
                for (int i = 0; i < 8; ++i) { const float cs = rp[i], sn = rp[8 + i]; y1[i] = x1[i] * cs - x2[i] * sn; y2[i] = x2[i] * cs + x1[i] * sn; }
                kk[0] = (v4u){pk2(y1[0], y1[1]), pk2(y1[2], y1[3]), pk2(y1[4], y1[5]), pk2(y1[6], y1[7])};
                kk[1] = (v4u){pk2(y2[0], y2[1]), pk2(y2[2], y2[3]), pk2(y2[4], y2[5]), pk2(y2[6], y2[7])}; }
        }
        __syncthreads();
#pragma unroll
        for (int i = 0; i < 4; ++i) { *(LAS v4u*)(L + row * SK_STR + (4 * hf + i) * 16) = kk[i]; *(LAS v4u*)(L + SX_V0 + row * SV_STR + (4 * hf + i) * 16) = vv[i]; }
        __syncthreads();
    }
    const int hq = kv * 8 + w;
    const float sink2 = sinks[hq] * 1.4426950408889634f;
    const int g16 = (lane >> 4) & 1, i16 = lane & 15, tq = i16 >> 2, tp = i16 & 3;
    const int vlane = SX_V0 + (4 * h + tq) * SV_STR + (16 * g16 + 4 * tp) * 2;
    const int klane = c * SK_STR + 16 * h;
#pragma unroll 1
    for (int i = 0; i < 4; ++i) {
        const int qs = blk * 128 + 32 * i; const size_t mq = (size_t)b * SEQ + qs + c;
        const bf16* qp = qkv + mq * SWA_N + hq * 64;
        bf16x8 qf[4];
#pragma unroll
        for (int ks = 1; ks < 4; ++ks) qf[ks] = *(const GAS bf16x8*)(qp + 16 * ks + 8 * h);
        { float x1[8], x2[8]; unpack8(*(const GAS v4u*)qp, x1); unpack8(*(const GAS v4u*)(qp + 8), x2); const float* rp = rope + (qs + c) * 16; float y[8];
#pragma unroll
          for (int k = 0; k < 8; ++k) { const float cs = rp[k], sn = rp[8 + k]; y[k] = h ? (x2[k] * cs + x1[k] * sn) : (x1[k] * cs - x2[k] * sn); }
          v4u t; t.x = pk2(y[0], y[1]); t.y = pk2(y[2], y[3]); t.z = pk2(y[4], y[5]); t.w = pk2(y[6], y[7]); qf[0] = __builtin_bit_cast(bf16x8, t); }
        const LAS unsigned char* Kb = L + klane + 32 * i * SK_STR;
        const LAS unsigned char* Vb = L + vlane + 32 * i * SV_STR;
        f32x16 S[5];
#pragma unroll
        for (int kbi = 0; kbi < 5; ++kbi) {
#pragma unroll
            for (int r = 0; r < 16; ++r) S[kbi][r] = 0.f;
#pragma unroll
            for (int ks = 0; ks < 4; ++ks) S[kbi] = __builtin_amdgcn_mfma_f32_32x32x16_bf16(*(const LAS bf16x8*)(Kb + 32 * kbi * SK_STR + 32 * ks), qf[ks], S[kbi], 0, 0, 0);
        }
        float mt = -INFINITY;
#pragma unroll
        for (int kbi = 0; kbi < 5; ++kbi) {
            const bool dead = (blk == 0) && (i + kbi < 4);
#pragma unroll
            for (int r = 0; r < 16; ++r) { const int cr = (r & 3) + 8 * (r >> 2) + 4 * h; float v = S[kbi][r] * 0.18033688011112042f;
                if (kbi == 0 && !(cr > c)) v = -INFINITY;
                if (kbi == 4 && !(cr <= c)) v = -INFINITY;
                if (dead) v = -INFINITY;
                S[kbi][r] = v; mt = fmaxf(mt, v); }
        }
        mt = xhalf_max(mt);
        const float m2 = fmaxf(mt, sink2);
        float rs = 0.f;
#pragma unroll
        for (int kbi = 0; kbi < 5; ++kbi)
#pragma unroll
            for (int r = 0; r < 16; ++r) { const float p = __builtin_amdgcn_exp2f(S[kbi][r] - m2); S[kbi][r] = p; rs += p; }
        const float inv = 1.0f / (xhalf_sum(rs) + __builtin_amdgcn_exp2f(sink2 - m2));
        f32x16 O[2];
#pragma unroll
        for (int db = 0; db < 2; ++db) {
#pragma unroll
            for (int r = 0; r < 16; ++r) O[db][r] = 0.f;
#pragma unroll
            for (int kbi = 0; kbi < 5; ++kbi)
#pragma unroll
                for (int s = 0; s < 2; ++s) {
                    const s16x4 lo_ = vtr(Vb + (32 * kbi + 16 * s) * SV_STR + 64 * db), hi_ = vtr(Vb + (32 * kbi + 16 * s + 8) * SV_STR + 64 * db);
                    const bf16x8 a = (bf16x8){lo_[0], lo_[1], lo_[2], lo_[3], hi_[0], hi_[1], hi_[2], hi_[3]};
                    O[db] = __builtin_amdgcn_mfma_f32_32x32x16_bf16(a, pack8(S[kbi], s), O[db], 0, 0, 0); }
        }
        bf16* op = o + mq * D + hq * 64 + 4 * h;
#pragma unroll
        for (int db = 0; db < 2; ++db)
#pragma unroll
            for (int g = 0; g < 4; ++g) { unsigned long long v = (unsigned long long)cvtpk_s(O[db][4 * g] * inv, O[db][4 * g + 1] * inv) | ((unsigned long long)cvtpk_s(O[db][4 * g + 2] * inv, O[db][4 * g + 3] * inv) << 32);
                *(GAS unsigned long long*)(op + 32 * db + 8 * g) = v; }
    }
}
__device__ __forceinline__ void swa_attn_phase(Frame& F, const bf16* qkv, const float* sinks, const float* rope, bf16* o) {
#pragma unroll 1
    for (int u = F.vcu; u < 512; u += F.G) swa_unit(F, qkv, sinks, rope, o, u >> 6, (u >> 4) & 3, u & 15);
    __syncthreads();
}

constexpr int GA_STR = 272, GB_STR = 320, GM_STR = 528, GX_B0 = 128 * GA_STR;
constexpr int GX_VS = GX_B0 + 128 * GM_STR;
static_assert(GX_VS + 512 <= RING_BYTES, "gmlp LDS");
__device__ __forceinline__ void gmlp_spatial_mfma(Frame& F, const bf16* z, const float* partv, const float* vg, const float* wsp, const float* bsp, bf16* y) {
    LAS unsigned char* L = F.lds + RING_OFF;
    const int lane = F.lane, wv = F.wave, c = lane & 31, h = lane >> 5;
    const int g = F.vcu & 15;
    __syncthreads();
    for (int e = F.tid; e < 2048; e += 512) { const int t = e >> 4, ch = e & 15; const float* src = wsp + (size_t)g * 16384 + t * 128 + 8 * ch;
        const f32x4 a = *(const GAS f32x4*)src, bq = *(const GAS f32x4*)(src + 4); float f[8] = {a.x, a.y, a.z, a.w, bq.x, bq.y, bq.z, bq.w};
#pragma unroll
        for (int k = 0; k < 8; ++k) f[k] = (8 * ch + k <= t) ? f[k] : 0.f;
        *(LAS v4u*)(L + t * GA_STR + ch * 16) = (v4u){pk2(f[0], f[1]), pk2(f[2], f[3]), pk2(f[4], f[5]), pk2(f[6], f[7])}; }
    const int tb = wv >> 1, wb0 = 2 * (wv & 1);
    const int g16 = (lane >> 4) & 1, i16 = lane & 15, tq = i16 >> 2, tp = i16 & 3;
    const LAS unsigned char* Ab = L + (32 * tb + c) * GA_STR + 16 * h;
    const LAS unsigned char* Bb = L + GX_B0 + (8 * h + tq) * GB_STR + (32 * wb0 + 16 * g16 + 4 * tp) * 2;
    const float vg0 = vg[g * 128 + 32 * wb0 + c], vg1 = vg[g * 128 + 32 * wb0 + 32 + c];
    f32x4 bias[4];
#pragma unroll
    for (int q = 0; q < 4; ++q) bias[q] = *(const GAS f32x4*)(bsp + g * 128 + 32 * tb + 8 * q + 4 * h);
    for (int cidx = F.vcu >> 4; cidx < 128; cidx += (F.G >> 4)) {
        const int r0 = cidx * 128;
        if (F.tid < 128) { const GAS f32x4* p = (const GAS f32x4*)(partv + (size_t)(r0 + F.tid) * 32); float sq = 0.f;
#pragma unroll
            for (int q = 0; q < 8; ++q) { const f32x4 v = p[q]; sq += (v.x + v.y) + (v.z + v.w); }
            *(LAS float*)(L + GX_VS + F.tid * 4) = 1.f / sqrtf(sq * (1.f / 2048.f) + EPS); }
        __syncthreads();
        for (int e = F.tid; e < 2048; e += 512) { const int s = e >> 4, ch = e & 15; float f[8]; unpack8(*(const GAS v4u*)(z + (size_t)(r0 + s) * GM_N + 2048 + g * 128 + 8 * ch), f);
            const float rs = *(const LAS float*)(L + GX_VS + s * 4);
            *(LAS v4u*)(L + GX_B0 + s * GB_STR + ch * 16) = (v4u){pk2(f[0] * rs, f[1] * rs), pk2(f[2] * rs, f[3] * rs), pk2(f[4] * rs, f[5] * rs), pk2(f[6] * rs, f[7] * rs)}; }
        __syncthreads();
        f32x16 acc0, acc1;
#pragma unroll
        for (int r = 0; r < 16; ++r) { acc0[r] = 0.f; acc1[r] = 0.f; }
#pragma unroll
        for (int ks = 0; ks < 8; ++ks) {
            if (ks <= 2 * tb + 1) {
                const bf16x8 a = *(const LAS bf16x8*)(Ab + 32 * ks);
                const s16x4 l0 = vtr(Bb + 16 * ks * GB_STR), h0 = vtr(Bb + (16 * ks + 4) * GB_STR), l1 = vtr(Bb + 16 * ks * GB_STR + 64), h1 = vtr(Bb + (16 * ks + 4) * GB_STR + 64);
                acc0 = __builtin_amdgcn_mfma_f32_32x32x16_bf16(a, (bf16x8){l0[0], l0[1], l0[2], l0[3], h0[0], h0[1], h0[2], h0[3]}, acc0, 0, 0, 0);
                acc1 = __builtin_amdgcn_mfma_f32_32x32x16_bf16(a, (bf16x8){l1[0], l1[1], l1[2], l1[3], h1[0], h1[1], h1[2], h1[3]}, acc1, 0, 0, 0);
            }
        }
        __syncthreads();
#pragma unroll
        for (int r = 0; r < 16; ++r) { const int t = 32 * tb + (r & 3) + 8 * (r >> 2) + 4 * h; const float bb = bias[r >> 2][r & 3];
            *(LAS float*)(L + GX_B0 + t * GM_STR + (32 * wb0 + c) * 4) = acc0[r] * vg0 + bb;
            *(LAS float*)(L + GX_B0 + t * GM_STR + (32 * wb0 + 32 + c) * 4) = acc1[r] * vg1 + bb; }
        __syncthreads();
        for (int e = F.tid; e < 2048; e += 512) { const int t = e >> 4, ch = e & 15; const size_t row = (size_t)(r0 + t);
            const f32x4 m0 = *(const LAS f32x4*)(L + GX_B0 + t * GM_STR + ch * 32), m1 = *(const LAS f32x4*)(L + GX_B0 + t * GM_STR + ch * 32 + 16);
            float uf[8]; unpack8(*(const GAS v4u*)(z + row * GM_N + g * 128 + 8 * ch), uf);
            *(GAS v4u*)(y + row * D + g * 128 + 8 * ch) = (v4u){pk2(uf[0] * m0.x, uf[1] * m0.y), pk2(uf[2] * m0.z, uf[3] * m0.w), pk2(uf[4] * m1.x, uf[5] * m1.y), pk2(uf[6] * m1.z, uf[7] * m1.w)}; }
        __syncthreads();
    }
}

__global__ void __launch_bounds__(NWAVES * 64, 2) mk_fwd(Args args) {
    extern __shared__ __attribute__((aligned(16))) unsigned char lds[];
    Frame F;
    F.lds = (LAS unsigned char*)lds;
    F.MISC = (volatile LAS unsigned*)(F.lds + MISC_OFF);
    F.tid = threadIdx.x; F.lane = F.tid & 63; F.wave = __builtin_amdgcn_readfirstlane(F.tid >> 6);
    F.G = gridDim.x; { const int bx = blockIdx.x; F.vcu = (F.G % 8 == 0) ? (bx % 8) * (F.G / 8) + bx / 8 : bx; }
    unsigned char* ws = args.ws;
    F.ctl = (gu32*)(ws + WS_CTL);
    for (int u = F.tid; u < (LDS_BYTES - LDSCTL_OFF) / 4; u += NWAVES * 64) ((LAS unsigned*)(F.lds + LDSCTL_OFF))[u] = 0u;
    __syncthreads();
    const int lo = args.ph_lo, hi = args.ph_hi;
    XcdBarrier bar; bar.bar = (unsigned*)(F.ctl + CW_BAR); bar.x = 0; bar.st = nullptr;
    if (hi - lo > 1) bar = xcd_barrier_post((unsigned*)(F.ctl + CW_BAR), F.MISC + 8);
    int ph = 0;
#define PH_BEGIN if (lo <= ph && ph < hi) { asm volatile("" : "+v"(F.tid), "+v"(F.lane), "+s"(F.wave), "+s"(F.vcu));
#define PH_END   if (ph + 1 < hi) xcd_barrier(bar); } ++ph;

    float* const h = args.out;
    bf16* const HB = (bf16*)(ws + WS_XN); bf16* const BIG = (bf16*)(ws + WS_BIG); bf16* const HID = (bf16*)(ws + WS_HID);
    float* const DEC = (float*)(ws + WS_SMALL + 1 * MiB); const float* const ROPE = (const float*)(ws + WS_SMALL + 2 * MiB);
    float* const PART = (float*)(ws + WS_SMALL + 3 * MiB); float* const PARTV = (float*)(ws + WS_SMALL + 5 * MiB); const bf16* const WFT = (const bf16*)(ws + WS_SMALL + 7 * MiB);
    const LAS float* const RS = (const LAS float*)(F.lds + RS_OFF);

    PH_BEGIN p0_prologue(F, args); PH_END

    for (int sl = 0; sl < 8; ++sl) {
        PH_BEGIN { panel_rstd(F, PART);
                   pg8::Gemm g{HB, (const bf16*)(ws + WS_W + sl * WS_FFN_STRIDE), M, 2 * FF, D}; pg8::StaticOrder S; S.init(M, 2 * FF, F.G, (int)blockIdx.x);
                   pg8::EpiSwiGLU E{HID, FF, RS};
                   pg8::gemm_phase<pg8::EpiSwiGLU, pg8::StaticOrder, true, true>(F.lds + RING_OFF, g, S, E); } PH_END
        PH_BEGIN { pg8::Gemm g{HID, (const bf16*)(ws + WS_W + sl * WS_FFN_STRIDE + WS_WO_OFF), M, D, FF}; pg8::StaticOrder S; S.init(M, D, F.G, (int)blockIdx.x, 4);
                   pg8::EpiResid E{HB, PART, D, 0.5f};
                   pg8::gemm_phase<pg8::EpiResid, pg8::StaticOrder, true, true>(F.lds + RING_OFF, g, S, E); } PH_END
        if (sl & 1) continue;
        const int L = sl >> 1;
        const bf16* win_t = (const bf16*)(ws + WS_MW + mw_win_off(L)); const bf16* wout_t = (const bf16*)(ws + WS_MW + mw_wout_off(L));
        if (L == 0 || L == 3) {
            PH_BEGIN { panel_rstd(F, PART);
                       pg8::Gemm g{HB, win_t, M, GM_N, D}; pg8::StaticOrder S; S.init(M, GM_N, F.G, (int)blockIdx.x);
                       pg8::EpiAct<1> E{BIG, GM_N, RS, PARTV, 8};
                       pg8::gemm_phase<pg8::EpiAct<1>, pg8::StaticOrder, true, true>(F.lds + RING_OFF, g, S, E); } PH_END
            PH_BEGIN gmlp_spatial_mfma(F, BIG, PARTV, args.mix_p0[L], args.mix_p1[L], args.mix_p2[L], HID); PH_END
        } else if (L == 1) {
            PH_BEGIN { panel_rstd(F, PART);
                       pg8::Gemm g{HB, win_t, M, SWA_N, D}; pg8::StaticOrder S; S.init(M, SWA_N, F.G, (int)blockIdx.x);
                       pg8::EpiAct<0> E{BIG, SWA_N, RS, nullptr, 0};
                       pg8::gemm_phase<pg8::EpiAct<0>, pg8::StaticOrder, true, true>(F.lds + RING_OFF, g, S, E); } PH_END
            PH_BEGIN swa_attn_phase(F, BIG, args.mix_p0[L], ROPE, HID); PH_END
        } else {
            PH_BEGIN { panel_rstd(F, PART); fox_fl(F, HB, WFT, args.mix_p0[L], DEC);
                       pg8::Gemm g{HB, win_t, M, FOX_N, D}; pg8::StaticOrder S; S.init(M, FOX_N, F.G, (int)blockIdx.x);
                       pg8::EpiAct<0> E{BIG, FOX_N, RS, nullptr, 0};
                       pg8::gemm_phase<pg8::EpiAct<0>, pg8::StaticOrder, true, true>(F.lds + RING_OFF, g, S, E); } PH_END
            PH_BEGIN fox_attn_phase(F, BIG, DEC, HID); PH_END
        }
        PH_BEGIN { pg8::Gemm g{HID, wout_t, M, D, D}; pg8::StaticOrder S; S.init(M, D, F.G, (int)blockIdx.x, 4);
                   pg8::EpiResid E{HB, PART, D, 1.0f};
                   pg8::gemm_phase<pg8::EpiResid, pg8::StaticOrder, true, true>(F.lds + RING_OFF, g, S, E); } PH_END
    }
    PH_BEGIN final_norm_phase(F, HB, h, args.final_norm); PH_END
#undef PH_BEGIN
#undef PH_END
}
constexpr int NPH = 1 + 8 * 2 + (3 + 3 + 3 + 3) + 1;

extern "C" void kernel_launch(void* const* d_in, const int* in_sizes, int n_in, void* d_out, int out_size, void* d_ws, size_t ws_size, hipStream_t stream) {
    static int grid = 0;
    if (grid == 0) {
        if (n_in != 46 || in_sizes[0] != M * D || out_size != M * D || ws_size < WS_END) { fprintf(stderr, "kernel_launch: unexpected shapes: n_in %d in0 %d out %d ws %zu (need %zu)\n", n_in, n_in > 0 ? in_sizes[0] : -1, out_size, ws_size, (size_t)WS_END); grid = -1; return; }
        int dev = 0, cus = 0;
        if (hipGetDevice(&dev) != hipSuccess || hipDeviceGetAttribute(&cus, hipDeviceAttributeMultiprocessorCount, dev) != hipSuccess) { grid = -1; return; }
        if (hipFuncSetAttribute((const void*)mk_fwd, hipFuncAttributeMaxDynamicSharedMemorySize, LDS_BYTES) != hipSuccess) { fprintf(stderr, "kernel_launch: hipFuncSetAttribute failed\n"); grid = -1; return; }
        (void)hipGetLastError();
        grid = cus;
        if (grid != 256) { fprintf(stderr, "kernel_launch: built for 256 CUs (the row-panel ownership of the fused norms), found %d\n", cus); grid = -1; return; }
    }
    if (grid < 0) return;
    if (hipMemsetAsync((char*)d_ws + WS_CTL, 0, CTL_ZERO_BYTES, stream) != hipSuccess) return;
    Args a{};
    a.x = (const float*)d_in[0];
    const int base[4] = {1, 13, 23, 33};
    for (int L = 0; L < 4; ++L) {
        const int b = base[L]; const bool gm = (L == 0 || L == 3);
        a.ffn_norm[2 * L] = (const float*)d_in[b]; a.ffn_wi[2 * L] = (const float*)d_in[b + 1]; a.ffn_wo[2 * L] = (const float*)d_in[b + 2];
        a.mix_norm[L] = (const float*)d_in[b + 3]; a.mix_win[L] = (const float*)d_in[b + 4];
        a.mix_p0[L] = (const float*)d_in[b + 5];
        int nx = b + 6;
        if (gm) { a.mix_p1[L] = (const float*)d_in[b + 6]; a.mix_p2[L] = (const float*)d_in[b + 7]; nx = b + 8; }
        a.mix_wout[L] = (const float*)d_in[nx];
        a.ffn_norm[2 * L + 1] = (const float*)d_in[nx + 1]; a.ffn_wi[2 * L + 1] = (const float*)d_in[nx + 2]; a.ffn_wo[2 * L + 1] = (const float*)d_in[nx + 3];
    }
    a.final_norm = (const float*)d_in[45];
    a.out = (float*)d_out; a.ws = (unsigned char*)d_ws;
#if MK_N_LAUNCHES == 1
    a.ph_lo = 0; a.ph_hi = NPH;
    hipLaunchKernelGGL(mk_fwd, dim3(grid), dim3(NWAVES * 64), LDS_BYTES, stream, a);
#else
    for (int p = 0; p < NPH; ++p) { a.ph_lo = p; a.ph_hi = p + 1; hipLaunchKernelGGL(mk_fwd, dim3(grid), dim3(NWAVES * 64), LDS_BYTES, stream, a); }
#endif
}
```

```cpp
#include <hip/hip_runtime.h>
#include <cstdio>
#include <cstdint>
namespace pg8 {
#define PG8_LAS __attribute__((address_space(3)))
typedef unsigned short bf16_t;
typedef short bf16x8 __attribute__((ext_vector_type(8)));
typedef float f32x4 __attribute__((ext_vector_type(4)));
typedef unsigned u32x4 __attribute__((ext_vector_type(4)));
constexpr int BM = 256, BK = 64, HALF = 128, HTB = HALF * BK * 2  , STAGE_BYTES = 8 * HTB, NXCD = 8, WGM = 8;

__host__ __device__ __forceinline__ int lds_byte(int r, int c) { const int st = (r >> 4) * 2 + (c >> 5), rr = r & 15, cc = c & 31, ob = rr * 64 + cc * 2; return st * 1024 + (ob ^ (((ob >> 9) & 1) << 5)); }
__host__ __device__ __forceinline__ void stage_rc(int b, int& R, int& C) { const int st = b / 1024, sb = b % 1024, swz = sb ^ (((sb >> 9) & 1) << 5); R = (st >> 1) * 16 + swz / 64; C = (st & 1) * 32 + (swz % 64) / 2; }
__host__ __device__ __forceinline__ int perm32(int rho) { const int n = rho >> 4, i = rho & 15; return 8 * (i >> 2) + 4 * n + (i & 3); }

struct Unit { int pm, pn; };
struct Gemm { const bf16_t* A; const bf16_t* Bt; int M, N, K; };

struct StaticOrder {
    int nM, nN, nwg, G, c, wgm;
    __host__ __device__ void init(int M, int N, int G_, int c_, int wgm_ = WGM) { nM = M / BM; nN = N / BM; nwg = nM * nN; G = G_; c = c_; wgm = wgm_; }
    __host__ __device__ bool next(int i, Unit& u) const {
        const long L = (long)i * G + c; if (L >= nwg) return false;
        int wgid = (int)L; { const int q = nwg / NXCD, r = nwg % NXCD, xcd = wgid % NXCD, off = wgid / NXCD; wgid = (xcd < r ? xcd * (q + 1) : r * (q + 1) + (xcd - r) * q) + off; }
        const int nig = wgm * nN, gid = wgid / nig, fm = gid * wgm, gsz = (nM - fm) < wgm ? (nM - fm) : wgm;
        u.pm = fm + ((wgid % nig) % gsz); u.pn = (wgid % nig) / gsz; return true;
    }
    __device__ __forceinline__ void a_ready(const Unit&) const {}
    __device__ __forceinline__ void done(const Unit&) const {}
};

__device__ __forceinline__ unsigned cvt_pk_bf16(float lo, float hi) { unsigned r; asm volatile("v_cvt_pk_bf16_f32 %0, %1, %2" : "=v"(r) : "v"(lo), "v"(hi)); return r; }
typedef float f32x2 __attribute__((ext_vector_type(2)));
__device__ __forceinline__ f32x2 gelu_pk(f32x2 v) {
    const f32x2 av = __builtin_elementwise_abs(v), d = av * 0.2316418882f + 1.0f;
    f32x2 t; t.x = __builtin_amdgcn_rcpf(d.x); t.y = __builtin_amdgcn_rcpf(d.y);
    f32x2 q = t * 0.5307027145f + (-0.7265760135f); q = q * t + 0.7107068705f; q = q * t + (-0.142248368f); q = q * t + 0.127414796f; q = q * t;
    const f32x2 s = (v * v) * (-0.72134752044f);
    f32x2 e; e.x = __builtin_amdgcn_exp2f(s.x); e.y = __builtin_amdgcn_exp2f(s.y);
    const f32x2 m = v * (q * e), r = v - m;
    f32x2 o; o.x = v.x < 0.f ? m.x : r.x; o.y = v.y < 0.f ? m.y : r.y; return o;
}

template <int ACT  > struct EpiBf16 {
    static constexpr bool PERM = true, AFTER_DRAIN = false; static_assert(ACT == 0 || ACT == 1, "EpiBf16: ACT is 0 (none) or 1 (gelu_pk)");
    bf16_t* O; int ldc; const float* bias; int split_cols; size_t split_stride; float scale0;
    __device__ __forceinline__ void operator()(const f32x4 (&acc)[2][2][4][2], const Unit& u, int wr, int wc, int fr, int fq) const {
        const int row0 = u.pm * BM + wr * 64 + fr; int colt = u.pn * BM; bf16_t* base = O;
        float sc = 1.f; if (split_cols) { const int t = colt / split_cols; base += (size_t)t * split_stride; colt -= t * split_cols; if (t == 0) sc = scale0; }
        const int col0 = colt + wc * 32 + 8 * fq, bcol0 = u.pn * BM + wc * 32 + 8 * fq;
        f32x4 bv[2][2];
#pragma unroll
        for (int bj = 0; bj < 2; ++bj)
#pragma unroll
            for (int n = 0; n < 2; ++n) bv[bj][n] = bias ? *(const f32x4*)(bias + bcol0 + bj * HALF + 4 * n) : (f32x4){0.f, 0.f, 0.f, 0.f};
#pragma unroll
        for (int ai = 0; ai < 2; ++ai)
#pragma unroll
            for (int m = 0; m < 4; ++m) { bf16_t* rowp = base + (size_t)(row0 + ai * HALF + m * 16) * ldc + col0;
#pragma unroll
                for (int bj = 0; bj < 2; ++bj) { f32x4 v0 = acc[ai][bj][m][0] + bv[bj][0], v1 = acc[ai][bj][m][1] + bv[bj][1];
                    if (ACT == 1) { f32x2 a = gelu_pk((f32x2){v0[0], v0[1]}), b = gelu_pk((f32x2){v0[2], v0[3]}), c = gelu_pk((f32x2){v1[0], v1[1]}), d = gelu_pk((f32x2){v1[2], v1[3]});
                        v0 = (f32x4){a.x, a.y, b.x, b.y}; v1 = (f32x4){c.x, c.y, d.x, d.y}; }
                    v0 = v0 * sc; v1 = v1 * sc; u32x4 w; w.x = cvt_pk_bf16(v0[0], v0[1]); w.y = cvt_pk_bf16(v0[2], v0[3]); w.z = cvt_pk_bf16(v1[0], v1[1]); w.w = cvt_pk_bf16(v1[2], v1[3]);
                    *(u32x4*)(rowp + bj * HALF) = w; } }
    }
};
template <class Epi, class Sched, bool ALIGN_EPI = false, bool SP2 = false>
__device__ __forceinline__ void gemm_phase(PG8_LAS unsigned char* lds, const Gemm g, const Sched& S, const Epi& E) {
    int tid_l = threadIdx.x; asm volatile("" : "+v"(tid_l));
    const int tid = tid_l, wid = __builtin_amdgcn_readfirstlane(tid >> 6), lane = tid & 63, wr = wid >> 2, wc = wid & 3, fr = lane & 15, fq = lane >> 4;
    const int K = g.K, nt = K / BK;
    unsigned voffA[2], voffB[2];
#pragma unroll
    for (int i = 0; i < 2; ++i) { int R, C; stage_rc(tid * 16 + i * 8192, R, C); const int Rb = Epi::PERM ? ((R & ~31) + perm32(R & 31)) : R;
        voffA[i] = (unsigned)(R * K + C) * 2u; voffB[i] = (unsigned)(Rb * BK + C) * 2u; }
    const size_t kstep = (size_t)(BK * 2);
    const size_t hstep = (size_t)HALF * K * 2;
    const size_t tstep = 2 * hstep;
    const size_t kstepB = (size_t)BM * BK * 2, hstepB = (size_t)HALF * BK * 2, tstepB = (size_t)nt * kstepB;
    const unsigned ldsw = (unsigned)wid * 1024u;
    const int aoff = lds_byte(wr * 64 + fr, fq * 8), boff = lds_byte(wc * 32 + fr, fq * 8);
#define PG8_SA(b, h) (((b) * 2 + (h)) * HTB)
#define PG8_SB(b, h) ((4 + (b) * 2 + (h)) * HTB)
#define PG8_STAGE(bufoff, gbase, voff) do { _Pragma("unroll") for (int _i = 0; _i < 2; ++_i) \
        __builtin_amdgcn_global_load_lds((const unsigned*)((const char*)(gbase) + (voff)[_i]), (PG8_LAS unsigned*)(lds + (bufoff) + ldsw + _i * 8192), 16, 0, 0); } while (0)
#define PG8_LDA(dst, b, h) do { _Pragma("unroll") for (int m = 0; m < 4; ++m) _Pragma("unroll") for (int k = 0; k < 2; ++k) dst[m][k] = *(const PG8_LAS bf16x8*)(lds + PG8_SA(b, h) + aoff + m * 2048 + k * 1024); } while (0)
#define PG8_LDB(dst, b, h) do { _Pragma("unroll") for (int n = 0; n < 2; ++n) _Pragma("unroll") for (int k = 0; k < 2; ++k) dst[n][k] = *(const PG8_LAS bf16x8*)(lds + PG8_SB(b, h) + boff + n * 2048 + k * 1024); } while (0)
#define PG8_MMA(ai, bj, At, Bt) do { __builtin_amdgcn_s_setprio(1); _Pragma("unroll") for (int m = 0; m < 4; ++m) _Pragma("unroll") for (int n = 0; n < 2; ++n) _Pragma("unroll") for (int k = 0; k < 2; ++k) \
        acc[ai][bj][m][n] = __builtin_amdgcn_mfma_f32_16x16x32_bf16(Bt[n][k], At[m][k], acc[ai][bj][m][n], 0, 0, 0); __builtin_amdgcn_s_setprio(0); } while (0)
#define PG8_WAIT_V(n) asm volatile("s_waitcnt vmcnt(" #n ")" ::: "memory")
#define PG8_WAIT_L(n) asm volatile("s_waitcnt lgkmcnt(" #n ")" ::: "memory")
#define PG8_BAR __builtin_amdgcn_s_barrier()
#define PG8_SCHED __builtin_amdgcn_sched_barrier(0)
    Unit cur, nxt; int ui = 0;
    if (!S.next(0, cur)) return;
    f32x4 acc[2][2][4][2];
#pragma unroll
    for (int a = 0; a < 2; ++a)
#pragma unroll
        for (int b = 0; b < 2; ++b)
#pragma unroll
            for (int m = 0; m < 4; ++m)
#pragma unroll
                for (int n = 0; n < 2; ++n) acc[a][b][m][n] = (f32x4){0.f, 0.f, 0.f, 0.f};
    bf16x8 At[4][2], B0[2][2], B1[2][2];
    const char* cA = (const char*)g.A + (size_t)cur.pm * tstep; const char* cB = (const char*)g.Bt + (size_t)cur.pn * tstepB;
    S.a_ready(cur);
    if constexpr (SP2) {
        PG8_STAGE(PG8_SB(0, 0), cB, voffB); PG8_STAGE(PG8_SB(0, 1), cB + hstepB, voffB); PG8_STAGE(PG8_SA(0, 0), cA, voffA); PG8_STAGE(PG8_SA(0, 1), cA + hstep, voffA);
        if (wr == 1) PG8_BAR;
        PG8_WAIT_V(2); PG8_BAR;
        PG8_STAGE(PG8_SB(1, 0), cB + kstepB, voffB); PG8_STAGE(PG8_SA(1, 0), cA + kstep, voffA); PG8_STAGE(PG8_SB(1, 1), cB + hstepB + kstepB, voffB);
        PG8_WAIT_V(6); PG8_BAR;
    } else {
        PG8_STAGE(PG8_SB(0, 0), cB, voffB); PG8_STAGE(PG8_SA(0, 0), cA, voffA); PG8_STAGE(PG8_SB(0, 1), cB + hstepB, voffB); PG8_STAGE(PG8_SA(0, 1), cA + hstep, voffA);
        if (wr == 1) PG8_BAR;
        PG8_WAIT_V(4); PG8_BAR;
        PG8_STAGE(PG8_SB(1, 0), cB + kstepB, voffB); PG8_STAGE(PG8_SA(1, 0), cA + kstep, voffA); PG8_STAGE(PG8_SB(1, 1), cB + hstepB + kstepB, voffB);
        PG8_WAIT_V(6); PG8_BAR;
    }
    for (;;) {
        const bool has_next = S.next(ui + 1, nxt);
        const char* nA = has_next ? (const char*)g.A + (size_t)nxt.pm * tstep : cA; const char* nB = has_next ? (const char*)g.Bt + (size_t)nxt.pn * tstepB : cB;
        for (int t = 0; t < nt; t += 2) {
            const bool last = (t == nt - 2);
            const char* a1 = cA + (size_t)(t + 1) * kstep;
            const char* a2 = last ? nA : cA + (size_t)(t + 2) * kstep; const char* b2 = last ? nB : cB + (size_t)(t + 2) * kstepB;
            const char* a3 = a2 + kstep; const char* b3 = b2 + kstepB;
            if (last && has_next) S.a_ready(nxt);
            if constexpr (SP2) {
            PG8_LDB(B0, 0, 0); PG8_LDB(B1, 0, 1); PG8_SCHED; PG8_LDA(At, 0, 0); PG8_STAGE(PG8_SA(1, 1), a1 + hstep, voffA);
            PG8_WAIT_V(8); PG8_WAIT_L(0); PG8_BAR; PG8_MMA(0, 0, At, B0); PG8_MMA(0, 1, At, B1); PG8_BAR; PG8_SCHED;
            PG8_LDA(At, 0, 1); PG8_STAGE(PG8_SB(0, 0), b2, voffB); PG8_STAGE(PG8_SB(0, 1), b2 + hstepB, voffB); PG8_STAGE(PG8_SA(0, 0), a2, voffA);
            PG8_WAIT_V(8); PG8_WAIT_L(0); PG8_BAR; PG8_MMA(1, 0, At, B0); PG8_MMA(1, 1, At, B1); PG8_BAR; PG8_SCHED;
            PG8_LDB(B0, 1, 0); PG8_LDB(B1, 1, 1); PG8_SCHED; PG8_LDA(At, 1, 0); PG8_STAGE(PG8_SA(0, 1), a2 + hstep, voffA);
            PG8_WAIT_V(8); PG8_WAIT_L(0); PG8_BAR; PG8_MMA(0, 0, At, B0); PG8_MMA(0, 1, At, B1); PG8_BAR; PG8_SCHED;
            PG8_LDA(At, 1, 1); PG8_STAGE(PG8_SB(1, 0), b3, voffB); PG8_STAGE(PG8_SB(1, 1), b3 + hstepB, voffB); PG8_STAGE(PG8_SA(1, 0), a3, voffA);
            PG8_WAIT_V(8); PG8_WAIT_L(0); PG8_BAR; PG8_MMA(1, 0, At, B0); PG8_MMA(1, 1, At, B1); PG8_BAR; PG8_SCHED;
            } else {
            PG8_LDB(B0, 0, 0); PG8_SCHED; PG8_LDA(At, 0, 0); PG8_STAGE(PG8_SA(1, 1), a1 + hstep, voffA);
            PG8_WAIT_L(8); PG8_BAR; PG8_WAIT_L(0); PG8_MMA(0, 0, At, B0); PG8_BAR; PG8_SCHED;
            PG8_LDB(B1, 0, 1); PG8_STAGE(PG8_SB(0, 0), b2, voffB);
            PG8_BAR; PG8_WAIT_L(0); PG8_MMA(0, 1, At, B1); PG8_BAR;
            PG8_LDA(At, 0, 1); PG8_STAGE(PG8_SA(0, 0), a2, voffA);
            PG8_BAR; PG8_WAIT_L(0); PG8_MMA(1, 0, At, B0); PG8_BAR; PG8_SCHED;
            PG8_STAGE(PG8_SB(0, 1), b2 + hstepB, voffB);
            PG8_WAIT_V(6); PG8_BAR; PG8_MMA(1, 1, At, B1); PG8_BAR;
            PG8_LDB(B0, 1, 0); PG8_SCHED; PG8_LDA(At, 1, 0); PG8_STAGE(PG8_SA(0, 1), a2 + hstep, voffA);
            PG8_WAIT_L(8); PG8_BAR; PG8_WAIT_L(0); PG8_MMA(0, 0, At, B0); PG8_BAR; PG8_SCHED;
            PG8_LDB(B1, 1, 1); PG8_STAGE(PG8_SB(1, 0), b3, voffB);
            PG8_BAR; PG8_WAIT_L(0); PG8_MMA(0, 1, At, B1); PG8_BAR;
            PG8_LDA(At, 1, 1); PG8_STAGE(PG8_SA(1, 0), a3, voffA);
            PG8_BAR; PG8_WAIT_L(0); PG8_MMA(1, 0, At, B0); PG8_BAR; PG8_SCHED;
            PG8_STAGE(PG8_SB(1, 1), b3 + hstepB, voffB);
            PG8_WAIT_V(6); PG8_BAR; PG8_MMA(1, 1, At, B1); PG8_BAR;
            }
        }
        if constexpr (ALIGN_EPI) { if (wr == 0) PG8_BAR; }
        if constexpr (!Epi::AFTER_DRAIN) { E(acc, cur, wr, wc, fr, fq); S.done(cur); }
        if (!has_next) break;
#pragma unroll
        for (int a = 0; a < 2; ++a)
#pragma unroll
            for (int b = 0; b < 2; ++b)
#pragma unroll
                for (int m = 0; m < 4; ++m)
#pragma unroll
                    for (int n = 0; n < 2; ++n) acc[a][b][m][n] = (f32x4){0.f, 0.f, 0.f, 0.f};
        cur = nxt; cA = nA; cB = nB; ++ui;
        if constexpr (ALIGN_EPI) { if (wr == 1) PG8_BAR; }
    }
    PG8_WAIT_V(0);
    if constexpr (!ALIGN_EPI) { if (wr == 0) PG8_BAR; }
    PG8_BAR;
    if constexpr (Epi::AFTER_DRAIN) { E.fused(acc, cur, wr, wc, fr, fq, lds, wid, lane); S.done(cur); }
#undef PG8_SA
#undef PG8_SB
#undef PG8_STAGE
#undef PG8_LDA
#undef PG8_LDB
#undef PG8_MMA
#undef PG8_WAIT_V
#undef PG8_WAIT_L
#undef PG8_BAR
#undef PG8_SCHED
}
}
namespace pg8 {
typedef unsigned u32x2 __attribute__((ext_vector_type(2)));
struct EpiResid {
    static constexpr bool PERM = true, AFTER_DRAIN = false;
    bf16_t* HB; float* part; int ldc; float coef;
    __device__ __forceinline__ void operator()(const f32x4 (&acc)[2][2][4][2], const Unit& u, int wr, int wc, int fr, int fq) const {
        const int row0 = u.pm * BM + wr * 64 + fr, col0 = u.pn * BM + wc * 32 + 8 * fq;
        u32x4 o[2][4][2];
#pragma unroll
        for (int ai = 0; ai < 2; ++ai)
#pragma unroll
            for (int m = 0; m < 4; ++m) { const bf16_t* rowp = HB + (size_t)(row0 + ai * HALF + m * 16) * ldc + col0;
#pragma unroll
                for (int bj = 0; bj < 2; ++bj) o[ai][m][bj] = *(const u32x4*)(rowp + bj * HALF); }
        asm volatile("" ::: "memory");
#pragma unroll
        for (int ai = 0; ai < 2; ++ai) {
            float smine = 0.f;
#pragma unroll
            for (int m = 0; m < 4; ++m) { bf16_t* rowp = HB + (size_t)(row0 + ai * HALF + m * 16) * ldc + col0; float s = 0.f;
#pragma unroll
                for (int bj = 0; bj < 2; ++bj) { const u32x4 w0 = o[ai][m][bj]; u32x4 w;
#pragma unroll
                    for (int k = 0; k < 4; ++k) { const float a0 = __builtin_bit_cast(float, w0[k] << 16) + acc[ai][bj][m][k >> 1][2 * (k & 1)] * coef, a1 = __builtin_bit_cast(float, w0[k] & 0xffff0000u) + acc[ai][bj][m][k >> 1][2 * (k & 1) + 1] * coef;
                        const unsigned pk = cvt_pk_bf16(a0, a1); w[k] = pk; const float r0 = __builtin_bit_cast(float, pk << 16), r1 = __builtin_bit_cast(float, pk & 0xffff0000u); s += r0 * r0 + r1 * r1; }
                    *(u32x4*)(rowp + bj * HALF) = w; }
                s += __shfl_xor(s, 16); s += __shfl_xor(s, 32);
                smine = (fq == m) ? s : smine; }
            part[(size_t)(row0 + ai * HALF + fq * 16) * 32 + u.pn * 4 + wc] = smine;
        }
    }
};
struct EpiSwiGLU {
    static constexpr bool PERM = true, AFTER_DRAIN = false;
    bf16_t* O; int ldc; const PG8_LAS float* rs;
    __device__ __forceinline__ static unsigned silu_mul_pk(f32x2 g, f32x2 u, float rl, float r2) {
        const f32x2 t = g * rl;
        f32x2 e; e.x = __builtin_amdgcn_exp2f(t.x); e.y = __builtin_amdgcn_exp2f(t.y);
        const f32x2 d = e + 1.0f; f32x2 q; q.x = __builtin_amdgcn_rcpf(d.x); q.y = __builtin_amdgcn_rcpf(d.y);
        const f32x2 o = ((g * u) * r2) * q; return cvt_pk_bf16(o.x, o.y); }
    __device__ __forceinline__ void operator()(const f32x4 (&acc)[2][2][4][2], const Unit& u, int wr, int wc, int fr, int fq) const {
        const int row0 = u.pm * BM + wr * 64 + fr, col0 = u.pn * HALF + wc * 32 + 8 * fq;
#pragma unroll
        for (int ai = 0; ai < 2; ++ai)
#pragma unroll
            for (int m = 0; m < 4; ++m) { bf16_t* rowp = O + (size_t)(row0 + ai * HALF + m * 16) * ldc + col0; const float r = rs[ai * HALF + wr * 64 + m * 16 + fr];
                const f32x4 g0 = acc[ai][0][m][0], g1 = acc[ai][0][m][1], u0 = acc[ai][1][m][0], u1 = acc[ai][1][m][1];
                const float rl = r * (-1.4426950408889634f), r2 = r * r;
                u32x4 w; w.x = silu_mul_pk((f32x2){g0[0], g0[1]}, (f32x2){u0[0], u0[1]}, rl, r2); w.y = silu_mul_pk((f32x2){g0[2], g0[3]}, (f32x2){u0[2], u0[3]}, rl, r2);
                w.z = silu_mul_pk((f32x2){g1[0], g1[1]}, (f32x2){u1[0], u1[1]}, rl, r2); w.w = silu_mul_pk((f32x2){g1[2], g1[3]}, (f32x2){u1[2], u1[3]}, rl, r2);
                *(u32x4*)rowp = w; }
    }
};
template <int ACT> struct EpiAct {
    static constexpr bool PERM = true, AFTER_DRAIN = false;
    bf16_t* O; int ldc; const PG8_LAS float* rs; float* partv; int pn_v0;
    __device__ __forceinline__ void operator()(const f32x4 (&acc)[2][2][4][2], const Unit& u, int wr, int wc, int fr, int fq) const {
        const int row0 = u.pm * BM + wr * 64 + fr, col0 = u.pn * BM + wc * 32 + 8 * fq;
        const bool stat = (partv != nullptr) && (u.pn >= pn_v0);
#pragma unroll
        for (int ai = 0; ai < 2; ++ai)
#pragma unroll
            for (int m = 0; m < 4; ++m) { const int row = row0 + ai * HALF + m * 16; bf16_t* rowp = O + (size_t)row * ldc + col0; const float r = rs[ai * HALF + wr * 64 + m * 16 + fr]; float s = 0.f;
#pragma unroll
                for (int bj = 0; bj < 2; ++bj) { f32x4 v0 = acc[ai][bj][m][0] * r, v1 = acc[ai][bj][m][1] * r;
                    if (ACT == 1) { f32x2 a = gelu_pk((f32x2){v0[0], v0[1]}), b = gelu_pk((f32x2){v0[2], v0[3]}), c = gelu_pk((f32x2){v1[0], v1[1]}), d = gelu_pk((f32x2){v1[2], v1[3]});
                        v0 = (f32x4){a.x, a.y, b.x, b.y}; v1 = (f32x4){c.x, c.y, d.x, d.y}; }
                    s += ((v0[0] * v0[0] + v0[1] * v0[1]) + (v0[2] * v0[2] + v0[3] * v0[3])) + ((v1[0] * v1[0] + v1[1] * v1[1]) + (v1[2] * v1[2] + v1[3] * v1[3]));
                    u32x4 w; w.x = cvt_pk_bf16(v0[0], v0[1]); w.y = cvt_pk_bf16(v0[2], v0[3]); w.z = cvt_pk_bf16(v1[0], v1[1]); w.w = cvt_pk_bf16(v1[2], v1[3]);
                    *(u32x4*)(rowp + bj * HALF) = w; }
                if (stat) { s += __shfl_xor(s, 16); s += __shfl_xor(s, 32); if (fq == 0) partv[(size_t)row * 32 + (u.pn - pn_v0) * 4 + wc] = s; } }
    }
};
}

#ifndef MK_N_LAUNCHES
#define MK_N_LAUNCHES 1
#endif

constexpr int NWAVES = 8;
constexpr int BATCH = 8, SEQ = 2048, D = 2048, FF = 5632, M = BATCH * SEQ;
constexpr float EPS = 1e-5f;
constexpr int GM_N = 4096, SWA_N = 2560, FOX_N = 6144, FOX_LD = 6160;
constexpr size_t MiB = 1u << 20;
constexpr size_t WS_CTL = 0, CTL_ZERO_BYTES = 1 * MiB;
constexpr size_t WS_W = 1 * MiB;
constexpr size_t WS_FFN_STRIDE = 66 * MiB, WS_WO_OFF = 44 * MiB;
constexpr size_t WS_MW = WS_W + 8 * WS_FFN_STRIDE;
constexpr size_t WS_XN = WS_MW + 98 * MiB;
constexpr size_t WS_BIG = WS_XN + 64 * MiB;
constexpr size_t WS_HID = WS_BIG + 192 * MiB;
constexpr size_t WS_SMALL = WS_HID + 176 * MiB;
constexpr size_t WS_END = WS_SMALL + 8 * MiB;
__host__ __device__ constexpr size_t mw_win_off(int L) { return (L == 0 ? 0 : L == 1 ? 24 : L == 2 ? 42 : 74) * MiB; }
__host__ __device__ constexpr size_t mw_wout_off(int L) { return (L == 0 ? 16 : L == 1 ? 34 : L == 2 ? 66 : 90) * MiB; }
constexpr int CW_BAR = 4096;
constexpr int RING_OFF = 0, RING_BYTES = 131072;
constexpr int LDSCTL_OFF = RING_BYTES, MISC_OFF = LDSCTL_OFF + 320;
constexpr int RS_OFF = LDSCTL_OFF + 1024;
constexpr int LDS_BYTES = 147456;

#define GAS __attribute__((address_space(1)))
#define LAS __attribute__((address_space(3)))
typedef unsigned short bf16;
typedef unsigned v4u __attribute__((ext_vector_type(4)));
typedef float f32x4 __attribute__((ext_vector_type(4)));
typedef short bf16x8 __attribute__((ext_vector_type(8)));
typedef GAS unsigned gu32;
typedef GAS unsigned long long gu64;
#define RLX_AGENT __ATOMIC_RELAXED, __HIP_MEMORY_SCOPE_AGENT
#define LDS_WAIT() asm volatile("s_waitcnt lgkmcnt(0)" ::: "memory")
#define VM_WAIT() asm volatile("s_waitcnt vmcnt(0)" ::: "memory")
__device__ __forceinline__ unsigned long long rt() { return __builtin_amdgcn_s_memrealtime(); }
__device__ __forceinline__ unsigned f2bf(float f) { unsigned u = __builtin_bit_cast(unsigned, f); return (u + 0x7fffu + ((u >> 16) & 1u)) >> 16; }
__device__ __forceinline__ unsigned pk2(float lo, float hi) { return f2bf(lo) | (f2bf(hi) << 16); }

#define XB_TMO      128
#define XB_XCNT(j)  (256  + 64 * (j))
#define XB_XSUB(j)  (1280 + 64 * (j))
#define XB_XGEN(j)  (2304 + 64 * (j))
#define XB_TOP      3328
#define XB_TOPGEN   3392
#define XCD_BAR_WORDS 3456
#define XB_SPIN_CAP (1u << 18)

__device__ __forceinline__ unsigned xb_ld(unsigned* p)              { return __hip_atomic_load(p, __ATOMIC_RELAXED, __HIP_MEMORY_SCOPE_AGENT); }
__device__ __forceinline__ unsigned xb_add(unsigned* p, unsigned v) { return __hip_atomic_fetch_add(p, v, __ATOMIC_RELAXED, __HIP_MEMORY_SCOPE_AGENT); }
__device__ __forceinline__ unsigned xb_xcc_id() { return (unsigned)__builtin_amdgcn_s_getreg((3 << 11) | 20) & 0xFu; }
#define XB_SPIN(cond, bar) do { unsigned _sp = 0; while (cond) { __builtin_amdgcn_s_sleep(1); \
    if ((++_sp & 255u) == 0u) { if (xb_ld(&(bar)[XB_TMO])) break; if (_sp > XB_SPIN_CAP) { atomicAdd(&(bar)[XB_TMO], 1u); break; } } } } while (0)

struct XcdBarrier {
    unsigned* bar; unsigned x;
    volatile LAS unsigned* st;
};

__device__ __forceinline__ XcdBarrier xcd_barrier_post(unsigned* bar, volatile LAS unsigned* st) {
    XcdBarrier b; b.bar = bar; b.x = xb_xcc_id(); b.st = st;
    if (threadIdx.x == 0) (void)xb_add(&bar[XB_XCNT(b.x)], 1u);
    return b;
}
__device__ __forceinline__ void xcd_barrier_complete(unsigned* bar, unsigned x, unsigned& nloc, unsigned& nx) {
    const unsigned G = gridDim.x * gridDim.y * gridDim.z;
    unsigned sum, cnt, mine, sp = 0u;
    for (;;) {
        sum = 0u; cnt = 0u; mine = 0u;
#pragma unroll
        for (unsigned j = 0; j < 16; ++j) { const unsigned c = xb_ld(&bar[XB_XCNT(j)]); sum += c; cnt += (c > 0u) ? 1u : 0u; mine = (j == x) ? c : mine; }
        if (sum == G) break;
        __builtin_amdgcn_s_sleep(1);
        if ((++sp & 255u) == 0u) { if (xb_ld(&bar[XB_TMO])) break; if (sp > XB_SPIN_CAP) { atomicAdd(&bar[XB_TMO], 1u); break; } }
    }
    nloc = mine > 0u ? mine : 1u; nx = cnt > 0u ? cnt : 1u;
}

__device__ __forceinline__ void xcd_barrier(const XcdBarrier& b) {
    asm volatile("s_waitcnt vmcnt(0)" ::: "memory");
    __syncthreads();
    if (threadIdx.x == 0) {
        unsigned* bar = b.bar;
        __builtin_amdgcn_s_waitcnt(0);
        unsigned nloc = b.st[0], nx = b.st[1];
        if (nloc == 0u) { xcd_barrier_complete(bar, b.x, nloc, nx); b.st[0] = nloc; b.st[1] = nx; }
        const unsigned old = xb_add(&bar[XB_XSUB(b.x)], 1u);
        const unsigned gen = old / nloc;
        if (old + 1u == (gen + 1u) * nloc) {
            __builtin_amdgcn_fence(__ATOMIC_RELEASE, "agent");
            asm volatile("s_waitcnt vmcnt(0)" ::: "memory");
            const unsigned og = xb_add(&bar[XB_TOP], 1u);
            const unsigned tg = og / nx;
            if (og + 1u == (tg + 1u) * nx) xb_add(&bar[XB_TOPGEN], 1u);
            else XB_SPIN(xb_ld(&bar[XB_TOPGEN]) == tg, bar);
            __builtin_amdgcn_fence(__ATOMIC_ACQUIRE, "agent");
            xb_add(&bar[XB_XGEN(b.x)], 1u);
            asm volatile("s_waitcnt vmcnt(0)" ::: "memory");
        } else {
            XB_SPIN(xb_ld(&bar[XB_XGEN(b.x)]) == gen, bar);
            __builtin_amdgcn_fence(__ATOMIC_ACQUIRE, "agent");
            asm volatile("s_waitcnt vmcnt(0)" ::: "memory");
        }
    }
    __syncthreads();
}

struct Args {
    const float* x;
    const float* ffn_norm[8]; const float* ffn_wi[8]; const float* ffn_wo[8];
    const float* mix_norm[4]; const float* mix_win[4]; const float* mix_wout[4];
    const float* mix_p0[4];
    const float* mix_p1[4];
    const float* mix_p2[4];
    const float* final_norm;
    float* out; unsigned char* ws; int ph_lo, ph_hi;
};
struct Frame {
    LAS unsigned char* lds;
    volatile LAS unsigned* MISC;
    gu32* ctl;
    int tid, lane, wave;
    int vcu, G;
};

__device__ __forceinline__ float wave_sum(float v) {
#pragma unroll
    for (int o = 1; o < 64; o <<= 1) v += __shfl_xor(v, o);
    return v;
}
__device__ __forceinline__ float bflo(unsigned w) { return __builtin_bit_cast(float, w << 16); }
__device__ __forceinline__ float bfhi(unsigned w) { return __builtin_bit_cast(float, w & 0xffff0000u); }
__device__ __forceinline__ void unpack8(const v4u w, float* f) {
    f[0] = bflo(w.x); f[1] = bfhi(w.x); f[2] = bflo(w.y); f[3] = bfhi(w.y); f[4] = bflo(w.z); f[5] = bfhi(w.z); f[6] = bflo(w.w); f[7] = bfhi(w.w);
}

__device__ __forceinline__ void transpose_item(const float* W, int ldw, int Kdst, bf16* WT, int k0, int n0, int drow0, LAS float* scr, int lane, const float* gk) {
#pragma unroll 8
    for (int i = 0; i < 32; ++i) { const int kk = 2 * i + (lane >> 5); scr[kk * 33 + (lane & 31)] = W[(size_t)(k0 + kk) * ldw + n0 + (lane & 31)]; }
    const int c = lane & 7;
    f32x4 ga = (f32x4){1.f, 1.f, 1.f, 1.f}, gb = ga;
    if (gk) { ga = *(const GAS f32x4*)(gk + k0 + 8 * c); gb = *(const GAS f32x4*)(gk + k0 + 8 * c + 4); }
    LDS_WAIT(); asm volatile("" ::: "memory");
#pragma unroll
    for (int j = 0; j < 4; ++j) { const int n = (lane >> 3) + 8 * j; const LAS float* s = scr + (8 * c) * 33 + n;
        v4u o; o.x = pk2(s[0 * 33] * ga.x, s[1 * 33] * ga.y); o.y = pk2(s[2 * 33] * ga.z, s[3 * 33] * ga.w); o.z = pk2(s[4 * 33] * gb.x, s[5 * 33] * gb.y); o.w = pk2(s[6 * 33] * gb.z, s[7 * 33] * gb.w);
        *(GAS v4u*)(WT + ((size_t)((drow0 >> 8) * (Kdst >> 6) + (k0 >> 6)) * 256 + (drow0 & 255) + n) * 64 + 8 * c) = o; }
    LDS_WAIT(); asm volatile("" ::: "memory");
}
template <bool SWI> __device__ __forceinline__ void convert_matrix(Frame& F, const float* W, int ldw, int K, int Ncols, bf16* WT, const float* gk) {
    LAS float* scr = (LAS float*)(F.lds + RING_OFF + F.wave * 16384);
    const int gw = F.vcu * NWAVES + F.wave, NGW = F.G * NWAVES;
    const int nblk = Ncols / 32, items = (K / 64) * nblk;
    for (int it = gw; it < items; it += NGW) { const int kb = it / nblk, nb = it - kb * nblk; const int n0 = 32 * nb; int dr = n0;
        if (SWI) { const int up = n0 >= FF ? 1 : 0, c = n0 - up * FF; dr = (c >> 7) * 256 + up * 128 + (c & 127); }
        transpose_item(W, ldw, K, WT, 64 * kb, n0, dr, scr, F.lane, gk); }
}
__device__ __forceinline__ void p0_prologue(Frame& F, const Args& a) {
    unsigned char* ws = a.ws;
    for (int s = 0; s < 8; ++s) {
        convert_matrix<true>(F, a.ffn_wi[s], 2 * FF, D, 2 * FF, (bf16*)(ws + WS_W + s * WS_FFN_STRIDE), a.ffn_norm[s]);
        convert_matrix<false>(F, a.ffn_wo[s], D, FF, D, (bf16*)(ws + WS_W + s * WS_FFN_STRIDE + WS_WO_OFF), nullptr);
    }
    for (int L = 0; L < 4; ++L) {
        const int n = (L == 1) ? SWA_N : (L == 2) ? FOX_N : GM_N, ld = (L == 2) ? FOX_LD : n;
        convert_matrix<false>(F, a.mix_win[L], ld, D, n, (bf16*)(ws + WS_MW + mw_win_off(L)), a.mix_norm[L]);
        convert_matrix<false>(F, a.mix_wout[L], D, D, D, (bf16*)(ws + WS_MW + mw_wout_off(L)), nullptr);
    }
    { bf16* wft = (bf16*)(ws + WS_SMALL + 7 * MiB); const float* w = a.mix_win[2]; const float* g = a.mix_norm[2];
      for (int i = F.vcu * 512 + F.tid; i < D * 16; i += F.G * 512) { const int k = i >> 4, n = i & 15; wft[n * D + k] = (bf16)f2bf(w[(size_t)k * FOX_LD + FOX_N + n] * g[k]); } }
    { const int gw = F.vcu * NWAVES + F.wave, NGW = F.G * NWAVES; bf16* hb = (bf16*)(ws + WS_XN); float* part = (float*)(ws + WS_SMALL + 3 * MiB);
      for (int m = gw; m < M; m += NGW) {
          const GAS f32x4* xr = (const GAS f32x4*)(a.x + (size_t)m * D) + F.lane; f32x4 v[8]; float s = 0.f;
#pragma unroll
          for (int j = 0; j < 8; ++j) { v[j] = xr[64 * j]; s += (v[j].x * v[j].x + v[j].y * v[j].y) + (v[j].z * v[j].z + v[j].w * v[j].w); }
          s = wave_sum(s);
          GAS unsigned long long* o8 = (GAS unsigned long long*)(hb + (size_t)m * D) + F.lane;
#pragma unroll
          for (int j = 0; j < 8; ++j) o8[64 * j] = (unsigned long long)pk2(v[j].x, v[j].y) | ((unsigned long long)pk2(v[j].z, v[j].w) << 32);
          if (F.lane < 32) part[(size_t)m * 32 + F.lane] = (F.lane == 0) ? s : 0.f; } }
    { float* rope = (float*)(ws + WS_SMALL + 2 * MiB);
      for (int i = F.vcu * 512 + F.tid; i < SEQ * 8; i += F.G * 512) { const int s = i >> 3, j = i & 7;
          const float invf = exp2f(-(float)j * 0.125f * 18.931568569324174f);
          const float ang = (float)s * invf; double r = (double)ang * 0.15915494309189535; r -= rint(r); const float rf = (float)r;
          rope[s * 16 + j] = __builtin_amdgcn_cosf(rf); rope[s * 16 + 8 + j] = __builtin_amdgcn_sinf(rf); } }
}
__device__ __forceinline__ int wg_panel() { const int c = blockIdx.x; return 8 * (c & 7) + ((c >> 3) & 7); }
__device__ __forceinline__ void panel_rstd(Frame& F, const float* part) {
    LAS float* RS = (LAS float*)(F.lds + RS_OFF);
    if (F.tid < 256) { const GAS f32x4* p = (const GAS f32x4*)(part + (size_t)(wg_panel() * 256 + F.tid) * 32); float s = 0.f;
#pragma unroll
        for (int q = 0; q < 8; ++q) { const f32x4 v = p[q]; s += (v.x + v.y) + (v.z + v.w); }
        RS[F.tid] = 1.f / sqrtf(s * (1.f / D) + EPS); }
    __syncthreads();
}
__device__ __forceinline__ void fox_fl(Frame& F, const bf16* HB, const bf16* WfT, const float* bfp, float* lgf) {
    const LAS float* RS = (const LAS float*)(F.lds + RS_OFF);
    if (F.wave < 4) {
        const int r = F.lane & 15, kq = F.lane >> 4, rl = ((int)blockIdx.x >> 6) * 64 + F.wave * 16, row0 = wg_panel() * 256;
        const bf16* ap = HB + (size_t)(row0 + rl + r) * D + 8 * kq; const bf16* bp = WfT + (size_t)r * D + 8 * kq;
        f32x4 acc = (f32x4){0.f, 0.f, 0.f, 0.f};
#pragma unroll 8
        for (int ks = 0; ks < 64; ++ks) acc = __builtin_amdgcn_mfma_f32_16x16x32_bf16(*(const GAS bf16x8*)(ap + 32 * ks), *(const GAS bf16x8*)(bp + 32 * ks), acc, 0, 0, 0);
        const float bb = bfp[r];
#pragma unroll
        for (int i = 0; i < 4; ++i) { const int rr = rl + 4 * kq + i; const float xx = acc[i] * RS[rr] + bb; lgf[(size_t)(row0 + rr) * 16 + r] = fminf(xx, 0.f) - log1pf(expf(-fabsf(xx))); }
    }
}

template <int FOX> __device__ __forceinline__ void rms_phase(Frame& F, const float* h, const float* g, bf16* xn, const float* wf, const float* bfp, float* lgf) {
    const int gw = F.vcu * NWAVES + F.wave, NGW = F.G * NWAVES;
    LAS float* WL = (LAS float*)(F.lds + RING_OFF);
    if (FOX) {
        for (int i = F.tid; i < 2048 * 16; i += 512) { const int k = i >> 4, c = i & 15; WL[c * 2048 + k] = wf[(size_t)k * FOX_LD + FOX_N + c]; }
        __syncthreads();
    }
    f32x4 gv[8];
#pragma unroll
    for (int j = 0; j < 8; ++j) gv[j] = ((const GAS f32x4*)g)[F.lane + 64 * j];
    for (int m = gw; m < M; m += NGW) {
        const GAS f32x4* xr = (const GAS f32x4*)(h + (size_t)m * D) + F.lane;
        f32x4 v[8]; float s = 0.f;
#pragma unroll
        for (int j = 0; j < 8; ++j) { v[j] = xr[64 * j]; s += (v[j].x * v[j].x + v[j].y * v[j].y) + (v[j].z * v[j].z + v[j].w * v[j].w); }
        const float rstd = 1.f / sqrtf(wave_sum(s) * (1.f / D) + EPS);
        GAS unsigned long long* o8 = (GAS unsigned long long*)(xn + (size_t)m * D) + F.lane;
#pragma unroll
        for (int j = 0; j < 8; ++j) { v[j] = v[j] * rstd * gv[j]; o8[64 * j] = (unsigned long long)pk2(v[j].x, v[j].y) | ((unsigned long long)pk2(v[j].z, v[j].w) << 32); }
        if (FOX) {
            float mine = 0.f;
#pragma unroll 1
            for (int c = 0; c < 16; ++c) { float a = 0.f;
#pragma unroll
                for (int j = 0; j < 8; ++j) { const f32x4 w = *(const LAS f32x4*)(WL + c * 2048 + 4 * (F.lane + 64 * j)); a += (v[j].x * w.x + v[j].y * w.y) + (v[j].z * w.z + v[j].w * w.w); }
                a = wave_sum(a); mine = (F.lane == c) ? a : mine; }
            if (F.lane < 16) { const float xx = mine + bfp[F.lane]; lgf[(size_t)m * 16 + F.lane] = fminf(xx, 0.f) - log1pf(expf(-fabsf(xx))); }
        }
    }
    if (FOX) __syncthreads();
}
__device__ __forceinline__ void final_norm_phase(Frame& F, const bf16* hb, float* out, const float* g) {
    const int gw = F.vcu * NWAVES + F.wave, NGW = F.G * NWAVES;
    f32x4 ga[4], gb[4];
#pragma unroll
    for (int j = 0; j < 4; ++j) { ga[j] = ((const GAS f32x4*)g)[2 * (F.lane + 64 * j)]; gb[j] = ((const GAS f32x4*)g)[2 * (F.lane + 64 * j) + 1]; }
    for (int m = gw; m < M; m += NGW) {
        const GAS v4u* xr = (const GAS v4u*)(hb + (size_t)m * D) + F.lane;
        float v[4][8]; float s = 0.f;
#pragma unroll
        for (int j = 0; j < 4; ++j) { unpack8(xr[64 * j], v[j]);
#pragma unroll
            for (int k = 0; k < 8; ++k) s += v[j][k] * v[j][k]; }
        const float rstd = 1.f / sqrtf(wave_sum(s) * (1.f / D) + EPS);
        GAS f32x4* o = (GAS f32x4*)(out + (size_t)m * D);
#pragma unroll
        for (int j = 0; j < 4; ++j) { o[2 * (F.lane + 64 * j)] = (f32x4){v[j][0], v[j][1], v[j][2], v[j][3]} * rstd * ga[j]; o[2 * (F.lane + 64 * j) + 1] = (f32x4){v[j][4], v[j][5], v[j][6], v[j][7]} * rstd * gb[j]; }
    }
}
__device__ __forceinline__ void silu_phase(Frame& F, const bf16* big, bf16* hid) {
    const size_t nv = (size_t)M * (FF / 8);
    for (size_t i = (size_t)F.vcu * 512 + F.tid; i < nv; i += (size_t)F.G * 512) {
        const size_t m = i / (FF / 8); const int j8 = (int)(i - m * (FF / 8));
        const v4u gw4 = *(const GAS v4u*)(big + m * (2 * FF) + 8 * j8), uw4 = *(const GAS v4u*)(big + m * (2 * FF) + FF + 8 * j8);
        float gf[8], uf[8], r[8]; unpack8(gw4, gf); unpack8(uw4, uf);
#pragma unroll
        for (int k = 0; k < 8; ++k) r[k] = gf[k] / (1.f + __expf(-gf[k])) * uf[k];
        v4u o; o.x = pk2(r[0], r[1]); o.y = pk2(r[2], r[3]); o.z = pk2(r[4], r[5]); o.w = pk2(r[6], r[7]);
        *(GAS v4u*)(hid + m * FF + 8 * j8) = o;
    }
}
__device__ __forceinline__ void gmlp_vstat_phase(Frame& F, const bf16* z, float* vstat) {
    const int gw = F.vcu * NWAVES + F.wave, NGW = F.G * NWAVES;
    for (int m = gw; m < M; m += NGW) {
        const GAS v4u* p = (const GAS v4u*)(z + (size_t)m * GM_N + 2048) + F.lane; float s = 0.f;
#pragma unroll
        for (int j = 0; j < 4; ++j) { float f[8]; unpack8(p[64 * j], f);
#pragma unroll
            for (int k = 0; k < 8; ++k) s += f[k] * f[k]; }
        s = wave_sum(s);
        if (F.lane == 0) vstat[m] = 1.f / sqrtf(s * (1.f / 2048.f) + EPS);
    }
}
__device__ __forceinline__ void gmlp_spatial_naive(Frame& F, const bf16* z, const float* vstat, const float* vg, const float* wsp, const float* bsp, bf16* y) {
    LAS float* WsT = (LAS float*)(F.lds + RING_OFF);
    LAS float* V = (LAS float*)(F.lds + RING_OFF + 65536);
    const int tt = F.tid >> 4, ww = F.tid & 15;
    for (int unit = F.vcu; unit < 2048; unit += F.G) {
        const int g = unit & 15, r0 = (unit >> 4) * 128;
        __syncthreads();
        for (int i = F.tid; i < 16384; i += 512) { const int t = i >> 7, s = i & 127; WsT[s * 128 + t] = (s <= t) ? wsp[(size_t)g * 16384 + i] : 0.f; }
        for (int i = F.tid; i < 16384; i += 512) { const int s = i >> 7, w = i & 127;
            const unsigned short b = z[(size_t)(r0 + s) * GM_N + 2048 + g * 128 + w];
            V[i] = __builtin_bit_cast(float, ((unsigned)b) << 16) * vstat[r0 + s] * vg[g * 128 + w]; }
        __syncthreads();
        float acc[4][8];
#pragma unroll
        for (int i = 0; i < 4; ++i)
#pragma unroll
            for (int j = 0; j < 8; ++j) acc[i][j] = 0.f;
        for (int s = 0; s < 128; ++s) {
            const f32x4 a = *(const LAS f32x4*)(WsT + s * 128 + tt * 4);
            const f32x4 v0 = *(const LAS f32x4*)(V + s * 128 + ww * 8), v1 = *(const LAS f32x4*)(V + s * 128 + ww * 8 + 4);
#pragma unroll
            for (int i = 0; i < 4; ++i) {
#pragma unroll
                for (int j = 0; j < 4; ++j) { acc[i][j] += a[i] * v0[j]; acc[i][4 + j] += a[i] * v1[j]; } }
        }
#pragma unroll
        for (int i = 0; i < 4; ++i) { const int t = tt * 4 + i; const size_t row = (size_t)(r0 + t); const float bias = bsp[g * 128 + t];
            float uf[8]; unpack8(*(const GAS v4u*)(z + row * GM_N + g * 128 + ww * 8), uf);
            v4u o; o.x = pk2(uf[0] * (acc[i][0] + bias), uf[1] * (acc[i][1] + bias)); o.y = pk2(uf[2] * (acc[i][2] + bias), uf[3] * (acc[i][3] + bias));
            o.z = pk2(uf[4] * (acc[i][4] + bias), uf[5] * (acc[i][5] + bias)); o.w = pk2(uf[6] * (acc[i][6] + bias), uf[7] * (acc[i][7] + bias));
            *(GAS v4u*)(y + row * D + g * 128 + ww * 8) = o; }
    }
    __syncthreads();
}
__device__ __forceinline__ void swa_naive(Frame& F, const bf16* qkv, const float* sinks, const float* rope, bf16* o) {
    const int gw = F.vcu * NWAVES + F.wave, NGW = F.G * NWAVES;
    for (int u = gw; u < 8192; u += NGW) {
        const int qb = u & 31, hq = (u >> 5) & 31, b = u >> 10, kv = hq >> 3;
        const int t = qb * 64 + F.lane; const size_t m = (size_t)b * SEQ + t;
        float q[64];
        { const GAS v4u* qp = (const GAS v4u*)(qkv + m * SWA_N + hq * 64);
#pragma unroll
          for (int i = 0; i < 8; ++i) unpack8(qp[i], q + 8 * i);
          const float* rp = rope + t * 16;
#pragma unroll
          for (int i = 0; i < 8; ++i) { const float c = rp[i], s = rp[8 + i], x1 = q[i], x2 = q[8 + i]; q[i] = x1 * c - x2 * s; q[8 + i] = x2 * c + x1 * s; }
#pragma unroll
          for (int i = 0; i < 64; ++i) q[i] *= 0.125f; }
        float acc[64];
#pragma unroll
        for (int i = 0; i < 64; ++i) acc[i] = 0.f;
        float mrun = sinks[hq], l = 1.f;
        const int s0 = (qb * 64 - 127) > 0 ? (qb * 64 - 127) : 0, s1 = qb * 64 + 63;
        for (int s = s0; s <= s1; ++s) {
            const size_t mk = (size_t)b * SEQ + s;
            const GAS v4u* kp = (const GAS v4u*)(qkv + mk * SWA_N + 2048 + kv * 64);
            float dot = 0.f;
            { float k0[16]; unpack8(kp[0], k0); unpack8(kp[1], k0 + 8);
              const float* rk = rope + s * 16;
#pragma unroll
              for (int i = 0; i < 8; ++i) { const float c = rk[i], sn = rk[8 + i], x1 = k0[i], x2 = k0[8 + i]; dot += q[i] * (x1 * c - x2 * sn) + q[8 + i] * (x2 * c + x1 * sn); } }
#pragma unroll
            for (int i = 2; i < 8; ++i) { float kf[8]; unpack8(kp[i], kf);
#pragma unroll
                for (int k = 0; k < 8; ++k) dot += q[8 * i + k] * kf[k]; }
            const bool valid = (s <= t) && (t - s < 128);
            if (valid) {
                if (dot > mrun) { const float corr = __expf(mrun - dot); l *= corr;
#pragma unroll
                    for (int i = 0; i < 64; ++i) acc[i] *= corr;
                    mrun = dot; }
                const float p = __expf(dot - mrun); l += p;
                const GAS v4u* vp = (const GAS v4u*)(qkv + mk * SWA_N + 2304 + kv * 64);
#pragma unroll
                for (int i = 0; i < 8; ++i) { float vf[8]; unpack8(vp[i], vf);
#pragma unroll
                    for (int k = 0; k < 8; ++k) acc[8 * i + k] += p * vf[k]; }
            }
        }
        const float inv = 1.f / l;
        GAS v4u* op = (GAS v4u*)(o + m * D + hq * 64);
#pragma unroll
        for (int i = 0; i < 8; ++i) { v4u w; w.x = pk2(acc[8 * i] * inv, acc[8 * i + 1] * inv); w.y = pk2(acc[8 * i + 2] * inv, acc[8 * i + 3] * inv);
            w.z = pk2(acc[8 * i + 4] * inv, acc[8 * i + 5] * inv); w.w = pk2(acc[8 * i + 6] * inv, acc[8 * i + 7] * inv); op[i] = w; }
    }
}
__device__ __forceinline__ void fox_cumsum_phase(Frame& F, float* dec) {
    const int gw = F.vcu * NWAVES + F.wave, NGW = F.G * NWAVES;
    for (int p = gw; p < BATCH * 16; p += NGW) {
        const int b = p >> 4, hh = p & 15;
        float* base = dec + ((size_t)b * SEQ + 32 * F.lane) * 16 + hh;
        float v[32]; float run = 0.f;
#pragma unroll
        for (int i = 0; i < 32; ++i) { run += base[i * 16]; v[i] = run; }
        float incl = run;
#pragma unroll
        for (int o = 1; o < 64; o <<= 1) { const float t = __shfl_up(incl, o); if (F.lane >= o) incl += t; }
        const float excl = incl - run;
#pragma unroll
        for (int i = 0; i < 32; ++i) base[i * 16] = (v[i] + excl) * 1.4426950408889634f;
    }
}
__device__ __forceinline__ void fox_naive(Frame& F, const bf16* qkv, const float* dec, bf16* o) {
    const int gw = F.vcu * NWAVES + F.wave, NGW = F.G * NWAVES;
    const int qi = F.lane & 31, half = F.lane >> 5;
    for (int u = gw; u < 8192; u += NGW) {
        const int b = u >> 10, hh = (u >> 6) & 15; int qb = u & 63; if ((b >> 1) & 1) qb = 63 - qb;
        const int t = qb * 32 + qi; const size_t m = (size_t)b * SEQ + t;
        float q[64];
        { const GAS v4u* qp = (const GAS v4u*)(qkv + m * FOX_N + hh * 128 + half * 64);
#pragma unroll
          for (int i = 0; i < 8; ++i) unpack8(qp[i], q + 8 * i);
#pragma unroll
          for (int i = 0; i < 64; ++i) q[i] *= 0.08838834764831845f; }
        const float Dt = dec[m * 16 + hh];
        float acc[64];
#pragma unroll
        for (int i = 0; i < 64; ++i) acc[i] = 0.f;
        float mrun = -1e30f, l = 0.f;
        const int s1 = qb * 32 + 31;
        for (int s = 0; s <= s1; ++s) {
            const size_t mk = (size_t)b * SEQ + s;
            const GAS v4u* kp = (const GAS v4u*)(qkv + mk * FOX_N + 2048 + hh * 128 + half * 64);
            float dot = 0.f;
#pragma unroll
            for (int i = 0; i < 8; ++i) { float kf[8]; unpack8(kp[i], kf);
#pragma unroll
                for (int k = 0; k < 8; ++k) dot += q[8 * i + k] * kf[k]; }
            dot += __shfl_xor(dot, 32);
            const float sc = dot + (Dt - dec[mk * 16 + hh]);
            if (s <= t) {
                if (sc > mrun) { const float corr = __expf(mrun - sc); l *= corr;
#pragma unroll
                    for (int i = 0; i < 64; ++i) acc[i] *= corr;
                    mrun = sc; }
                const float p = __expf(sc - mrun); l += p;
                const GAS v4u* vp = (const GAS v4u*)(qkv + mk * FOX_N + 4096 + hh * 128 + half * 64);
#pragma unroll
                for (int i = 0; i < 8; ++i) { float vf[8]; unpack8(vp[i], vf);
#pragma unroll
                    for (int k = 0; k < 8; ++k) acc[8 * i + k] += p * vf[k]; }
            }
        }
        const float inv = 1.f / l;
        GAS v4u* op = (GAS v4u*)(o + m * D + hh * 128 + half * 64);
#pragma unroll
        for (int i = 0; i < 8; ++i) { v4u w; w.x = pk2(acc[8 * i] * inv, acc[8 * i + 1] * inv); w.y = pk2(acc[8 * i + 2] * inv, acc[8 * i + 3] * inv);
            w.z = pk2(acc[8 * i + 4] * inv, acc[8 * i + 5] * inv); w.w = pk2(acc[8 * i + 6] * inv, acc[8 * i + 7] * inv); op[i] = w; }
    }
}

typedef float f32x16 __attribute__((ext_vector_type(16)));
typedef short s16x4 __attribute__((ext_vector_type(4)));
typedef short v4i16_t __attribute__((ext_vector_type(4)));
typedef float f32x2_t __attribute__((ext_vector_type(2))); typedef __bf16 bf16x2_t __attribute__((ext_vector_type(2)));
__device__ __forceinline__ unsigned cvtpk_s(float lo, float hi) { f32x2_t v = {lo, hi}; bf16x2_t r = __builtin_convertvector(v, bf16x2_t); return __builtin_bit_cast(unsigned, r); }
__device__ __forceinline__ s16x4 vtr(const LAS unsigned char* p) { return __builtin_bit_cast(s16x4, __builtin_amdgcn_ds_read_tr16_b64_v4i16((LAS v4i16_t*)p)); }
__device__ __forceinline__ float xhalf_max(float m) { float a = m, b = m; asm volatile("s_nop 1\n\tv_permlane32_swap_b32 %0, %1\n\ts_nop 1" : "+v"(a), "+v"(b)); return fmaxf(a, b); }
__device__ __forceinline__ float xhalf_sum(float m) { float a = m, b = m; asm volatile("s_nop 1\n\tv_permlane32_swap_b32 %0, %1\n\ts_nop 1" : "+v"(a), "+v"(b)); return a + b; }
__device__ __forceinline__ bf16x8 pack8(const f32x16& x, int s) {
    v4u p; p.x = cvtpk_s(x[8 * s], x[8 * s + 1]); p.y = cvtpk_s(x[8 * s + 2], x[8 * s + 3]); p.z = cvtpk_s(x[8 * s + 4], x[8 * s + 5]); p.w = cvtpk_s(x[8 * s + 6], x[8 * s + 7]);
    return __builtin_bit_cast(bf16x8, p); }
constexpr int FK_STR = 272, FV_STR = 320, FK_BYTES = 64 * FK_STR, FV_BYTES = 64 * FV_STR;
constexpr int FX_K0 = 0, FX_V0 = 2 * FK_BYTES, FX_D0 = FX_V0 + 3 * FV_BYTES;
static_assert(FX_D0 + 8192 + 64 <= RING_BYTES, "fox attention LDS");
__device__ __forceinline__ void fox_stage_a(f32x16& s0, f32x16& s1, const bf16x8 (&qf)[8], const LAS unsigned char* Kb, const LAS float* Db, bool diag, int qpos, int kb0) {
#pragma unroll
    for (int r = 0; r < 16; ++r) { s0[r] = 0.f; s1[r] = 0.f; }
#pragma unroll
    for (int ks = 0; ks < 8; ++ks) {
        const bf16x8 a0 = *(const LAS bf16x8*)(Kb + 32 * ks), a1 = *(const LAS bf16x8*)(Kb + 32 * FK_STR + 32 * ks);
        s0 = __builtin_amdgcn_mfma_f32_32x32x16_bf16(a0, qf[ks], s0, 0, 0, 0);
        s1 = __builtin_amdgcn_mfma_f32_32x32x16_bf16(a1, qf[ks], s1, 0, 0, 0); }
#pragma unroll
    for (int g = 0; g < 4; ++g) { const f32x4 d0 = *(const LAS f32x4*)(Db + 8 * g), d1 = *(const LAS f32x4*)(Db + 32 + 8 * g);
#pragma unroll
        for (int i = 0; i < 4; ++i) { s0[4 * g + i] = s0[4 * g + i] * 0.12751743074602467f - d0[i]; s1[4 * g + i] = s1[4 * g + i] * 0.12751743074602467f - d1[i]; } }
    if (diag) {
#pragma unroll
        for (int r = 0; r < 16; ++r) { const int kv = kb0 + (r & 3) + 8 * (r >> 2); if (kv > qpos) s0[r] = -INFINITY; if (kv + 32 > qpos) s1[r] = -INFINITY; }
    }
}
__device__ __forceinline__ void fox_stage_b(f32x16& s0, f32x16& s1, f32x16 (&O)[4], float& m, float& l, const LAS unsigned char* Vb) {
    float mt = fmaxf(s0[0], s1[0]);
#pragma unroll
    for (int r = 1; r < 16; ++r) mt = fmaxf(mt, fmaxf(s0[r], s1[r]));
    mt = xhalf_max(mt);
    const float mn = fmaxf(m, mt), alpha = __builtin_amdgcn_exp2f(m - mn); m = mn;
    float rs = 0.f;
#pragma unroll
    for (int r = 0; r < 16; ++r) { s0[r] = __builtin_amdgcn_exp2f(s0[r] - mn); s1[r] = __builtin_amdgcn_exp2f(s1[r] - mn); rs += s0[r] + s1[r]; }
    l = l * alpha + rs;
    if (!__all(alpha == 1.0f)) {
#pragma unroll
        for (int i = 0; i < 4; ++i)
#pragma unroll
            for (int r = 0; r < 16; ++r) O[i][r] *= alpha; }
    const bf16x8 p00 = pack8(s0, 0), p01 = pack8(s0, 1), p10 = pack8(s1, 0), p11 = pack8(s1, 1);
#pragma unroll
    for (int db = 0; db < 4; ++db) {
#define FOX_VT(kb_, s_) ({ const s16x4 lo_ = vtr(Vb + (32 * (kb_) + 16 * (s_)) * FV_STR + 64 * db), hi_ = vtr(Vb + (32 * (kb_) + 16 * (s_) + 8) * FV_STR + 64 * db); \
                   (bf16x8){lo_[0], lo_[1], lo_[2], lo_[3], hi_[0], hi_[1], hi_[2], hi_[3]}; })
        O[db] = __builtin_amdgcn_mfma_f32_32x32x16_bf16(FOX_VT(0, 0), p00, O[db], 0, 0, 0);
        O[db] = __builtin_amdgcn_mfma_f32_32x32x16_bf16(FOX_VT(0, 1), p01, O[db], 0, 0, 0);
        O[db] = __builtin_amdgcn_mfma_f32_32x32x16_bf16(FOX_VT(1, 0), p10, O[db], 0, 0, 0);
        O[db] = __builtin_amdgcn_mfma_f32_32x32x16_bf16(FOX_VT(1, 1), p11, O[db], 0, 0, 0);
#undef FOX_VT
    }
}
__device__ __forceinline__ void fox_unit(Frame& F, const bf16* qkv, bf16* o, int b, int hh, int qblk) {
    const int lane = F.lane, w = F.wave, c = lane & 31, h = lane >> 5;
    LAS unsigned char* L = F.lds + RING_OFF;
    const int q0 = qblk * 256 + 32 * w;
    const size_t mq = (size_t)b * SEQ + q0 + c;
    bf16x8 qf[8];
#pragma unroll
    for (int ks = 0; ks < 8; ++ks) qf[ks] = *(const GAS bf16x8*)(qkv + mq * FOX_N + hh * 128 + 16 * ks + 8 * h);
    f32x16 O[4];
#pragma unroll
    for (int i = 0; i < 4; ++i)
#pragma unroll
        for (int r = 0; r < 16; ++r) O[i][r] = 0.f;
    float m = -1e30f, l = 0.f;
    const int ntiles = 4 * (qblk + 1);
    const int srow = F.tid >> 3, sch = F.tid & 7;
    const bf16* kg = qkv + ((size_t)b * SEQ + srow) * FOX_N + 2048 + hh * 128 + sch * 8;
    kg += (size_t)(ntiles - 1) * 64 * FOX_N;
    v4u k0 = *(const GAS v4u*)kg, k1 = *(const GAS v4u*)(kg + 64), v0 = *(const GAS v4u*)(kg + 2048), v1 = *(const GAS v4u*)(kg + 2048 + 64);
    __syncthreads();
    *(LAS v4u*)(L + FX_K0 + srow * FK_STR + sch * 16) = k0; *(LAS v4u*)(L + FX_K0 + srow * FK_STR + sch * 16 + 128) = k1;
    *(LAS v4u*)(L + FX_V0 + srow * FV_STR + sch * 16) = v0; *(LAS v4u*)(L + FX_V0 + srow * FV_STR + sch * 16 + 128) = v1;
    __syncthreads();
    const int g16 = (lane >> 4) & 1, i16 = lane & 15, tq = i16 >> 2, tp = i16 & 3;
    const int vlane = (4 * h + tq) * FV_STR + (16 * g16 + 4 * tp) * 2;
    const int klane = c * FK_STR + 16 * h;
    const bool late = (w >= 4);
    f32x16 s0, s1; bool pend = false; int vcur = 0, vprev = 0;
    for (int jj = 0; jj < ntiles; ++jj) {
        const int j = ntiles - 1 - jj, cur = jj & 1; const bool more = (jj + 1) < ntiles;
        if (more) { kg -= (size_t)64 * FOX_N;
            k0 = *(const GAS v4u*)kg; k1 = *(const GAS v4u*)(kg + 64); v0 = *(const GAS v4u*)(kg + 2048); v1 = *(const GAS v4u*)(kg + 2048 + 64); }
        if (late && pend) { fox_stage_b(s0, s1, O, m, l, L + FX_V0 + vprev * FV_BYTES + vlane); pend = false; }
        if (64 * j <= q0 + 31) {
            fox_stage_a(s0, s1, qf, L + FX_K0 + cur * FK_BYTES + klane, (const LAS float*)(L + FX_D0) + 64 * j + 4 * h, 64 * j + 63 > q0, q0 + c, 64 * j + 4 * h);
            if (late) pend = true; else fox_stage_b(s0, s1, O, m, l, L + FX_V0 + vcur * FV_BYTES + vlane);
        }
        const int vnext = (vcur == 2) ? 0 : vcur + 1;
        if (more) { const int nx = cur ^ 1;
            *(LAS v4u*)(L + FX_K0 + nx * FK_BYTES + srow * FK_STR + sch * 16) = k0; *(LAS v4u*)(L + FX_K0 + nx * FK_BYTES + srow * FK_STR + sch * 16 + 128) = k1;
            *(LAS v4u*)(L + FX_V0 + vnext * FV_BYTES + srow * FV_STR + sch * 16) = v0; *(LAS v4u*)(L + FX_V0 + vnext * FV_BYTES + srow * FV_STR + sch * 16 + 128) = v1;
        }
        vprev = vcur; vcur = vnext;
        __syncthreads();
    }
    if (late && pend) fox_stage_b(s0, s1, O, m, l, L + FX_V0 + vprev * FV_BYTES + vlane);
    const float inv = 1.0f / xhalf_sum(l);
    bf16* op = o + mq * D + hh * 128 + 4 * h;
#pragma unroll
    for (int db = 0; db < 4; ++db)
#pragma unroll
        for (int g = 0; g < 4; ++g) { unsigned long long v = (unsigned long long)cvtpk_s(O[db][4 * g] * inv, O[db][4 * g + 1] * inv) | ((unsigned long long)cvtpk_s(O[db][4 * g + 2] * inv, O[db][4 * g + 3] * inv) << 32);
            *(GAS unsigned long long*)(op + 32 * db + 8 * g) = v; }
}
__device__ __forceinline__ void fox_attn_phase(Frame& F, const bf16* qkv, const float* lgf, bf16* o) {
    LAS unsigned char* L = F.lds + RING_OFF;
    for (int su = F.vcu; su < 256; su += F.G) {
        const int bh = su >> 1, set = su & 1, b = bh >> 4, hh = bh & 15;
        { LAS float* DL = (LAS float*)(L + FX_D0); LAS float* WT = DL + 2048;
          const float* src = lgf + ((size_t)b * SEQ + 4 * F.tid) * 16 + hh;
          const float p1 = src[0], p2 = p1 + src[16], p3 = p2 + src[32], p4 = p3 + src[48];
          float incl = p4;
#pragma unroll
          for (int ofs = 1; ofs < 64; ofs <<= 1) { const float t = __shfl_up(incl, ofs); if (F.lane >= ofs) incl += t; }
          __syncthreads();
          if (F.lane == 63) WT[F.wave] = incl;
          __syncthreads();
          float base = 0.f;
#pragma unroll
          for (int w = 0; w < NWAVES; ++w) base += (w < F.wave) ? WT[w] : 0.f;
          const float ex = base + incl - p4;
          *(LAS f32x4*)(DL + 4 * F.tid) = (f32x4){ex + p1, ex + p2, ex + p3, ex + p4} * 1.4426950408889634f;
          __syncthreads(); }
#pragma unroll 1
        for (int qi = 0; qi < 4; ++qi) { const int qblk = set ? (qi == 0 ? 6 : qi == 1 ? 5 : qi == 2 ? 2 : 1) : (qi == 0 ? 7 : qi == 1 ? 4 : qi == 2 ? 3 : 0);
            fox_unit(F, qkv, o, b, hh, qblk); }
    }
    __syncthreads();
}

constexpr int SK_STR = 144, SV_STR = 192, SX_V0 = 256 * SK_STR;
static_assert(SX_V0 + 256 * SV_STR <= RING_BYTES, "swa attention LDS");
__device__ __forceinline__ void swa_unit(Frame& F, const bf16* qkv, const float* sinks, const float* rope, bf16* o, int b, int kv, int blk) {
    const int lane = F.lane, w = F.wave, c = lane & 31, h = lane >> 5;
    LAS unsigned char* L = F.lds + RING_OFF;
    {
        const int row = F.tid >> 1, hf = F.tid & 1, kpos = (blk - 1) * 128 + row;
        v4u kk[4], vv[4];
#pragma unroll
        for (int i = 0; i < 4; ++i) { kk[i] = (v4u){0u, 0u, 0u, 0u}; vv[i] = (v4u){0u, 0u, 0u, 0u}; }
        if (kpos >= 0) {
            const bf16* kp = qkv + ((size_t)b * SEQ + kpos) * SWA_N + 2048 + kv * 64 + hf * 32;
#pragma unroll
            for (int i = 0; i < 4; ++i) { kk[i] = *(const GAS v4u*)(kp + 8 * i); vv[i] = *(const GAS v4u*)(kp + 256 + 8 * i); }
            if (hf == 0) { float x1[8], x2[8]; unpack8(kk[0], x1); unpack8(kk[1], x2); const float* rp = rope + kpos * 16; float y1[8], y2[8];
#pragma unroll
                for (int i = 0; i < 8; ++i) { const float cs = rp[i], sn = rp[8 + i]; y1[i] = x1[i] * cs - x2[i] * sn; y2[i] = x2[i] * cs + x1[i] * sn; }
                kk[0] = (v4u){pk2(y1[0], y1[1]), pk2(y1[2], y1[3]), pk2(y1[4], y1[5]), pk2(y1[6], y1[7])};
                kk[1] = (v4u){pk2(y2[0], y2[1]), pk2(y2[2], y2[3]), pk2(y2[4], y2[5]), pk2(y2[6], y2[7])}; }
        }
        __syncthreads();
#pragma unroll
        for (int i = 0; i < 4; ++i) { *(LAS v4u*)(L + row * SK_STR + (4 * hf + i) * 16) = kk[i]; *(LAS v4u*)(L + SX_V0 + row * SV_STR + (4 * hf + i) * 16) = vv[i]; }
        __syncthreads();
    }
    const int hq = kv * 8 + w;
    const float sink2 = sinks[hq] * 1.4426950408889634f;
    const int g16 = (lane >> 4) & 1, i16 = lane & 15, tq = i16 >> 2, tp = i16 & 3;
    const int vlane = SX_V0 + (4 * h + tq) * SV_STR + (16 * g16 + 4 * tp) * 2;
    const int klane = c * SK_STR + 16 * h;
#pragma unroll 1
    for (int i = 0; i < 4; ++i) {
        const int qs = blk * 128 + 32 * i; const size_t mq = (size_t)b * SEQ + qs + c;
        const bf16* qp = qkv + mq * SWA_N + hq * 64;
        bf16x8 qf[4];
#pragma unroll
        for (int ks = 1; ks < 4; ++ks) qf[ks] = *(const GAS bf16x8*)(qp + 16 * ks + 8 * h);
        { float x1[8], x2[8]; unpack8(*(const GAS v4u*)qp, x1); unpack8(*(const GAS v4u*)(qp + 8), x2); const float* rp = rope + (qs + c) * 16; float y[8];
#pragma unroll
          for (int k = 0; k < 8; ++k) { const float cs = rp[k], sn = rp[8 + k]; y[k] = h ? (x2[k] * cs + x1[k] * sn) : (x1[k] * cs - x2[k] * sn); }
          v4u t; t.x = pk2(y[0], y[1]); t.y = pk2(y[2], y[3]); t.z = pk2(y[4], y[5]); t.w = pk2(y[6], y[7]); qf[0] = __builtin_bit_cast(bf16x8, t); }
        const LAS unsigned char* Kb = L + klane + 32 * i * SK_STR;
        const LAS unsigned char* Vb = L + vlane + 32 * i * SV_STR;
        f32x16 S[5];
#pragma unroll
        for (int kbi = 0; kbi < 5; ++kbi) {
#pragma unroll
            for (int r = 0; r < 16; ++r) S[kbi][r] = 0.f;
#pragma unroll
            for (int ks = 0; ks < 4; ++ks) S[kbi] = __builtin_amdgcn_mfma_f32_32x32x16_bf16(*(const LAS bf16x8*)(Kb + 32 * kbi * SK_STR + 32 * ks), qf[ks], S[kbi], 0, 0, 0);
        }
        float mt = -INFINITY;
#pragma unroll
        for (int kbi = 0; kbi < 5; ++kbi) {
            const bool dead = (blk == 0) && (i + kbi < 4);
#pragma unroll
            for (int r = 0; r < 16; ++r) { const int cr = (r & 3) + 8 * (r >> 2) + 4 * h; float v = S[kbi][r] * 0.18033688011112042f;
                if (kbi == 0 && !(cr > c)) v = -INFINITY;
                if (kbi == 4 && !(cr <= c)) v = -INFINITY;
                if (dead) v = -INFINITY;
                S[kbi][r] = v; mt = fmaxf(mt, v); }
        }
        mt = xhalf_max(mt);
        const float m2 = fmaxf(mt, sink2);
        float rs = 0.f;
#pragma unroll
        for (int kbi = 0; kbi < 5; ++kbi)
#pragma unroll
            for (int r = 0; r < 16; ++r) { const float p = __builtin_amdgcn_exp2f(S[kbi][r] - m2); S[kbi][r] = p; rs += p; }
        const float inv = 1.0f / (xhalf_sum(rs) + __builtin_amdgcn_exp2f(sink2 - m2));
        f32x16 O[2];
#pragma unroll
        for (int db = 0; db < 2; ++db) {
#pragma unroll
            for (int r = 0; r < 16; ++r) O[db][r] = 0.f;
#pragma unroll
            for (int kbi = 0; kbi < 5; ++kbi)
#pragma unroll
                for (int s = 0; s < 2; ++s) {
                    const s16x4 lo_ = vtr(Vb + (32 * kbi + 16 * s) * SV_STR + 64 * db), hi_ = vtr(Vb + (32 * kbi + 16 * s + 8) * SV_STR + 64 * db);
                    const bf16x8 a = (bf16x8){lo_[0], lo_[1], lo_[2], lo_[3], hi_[0], hi_[1], hi_[2], hi_[3]};
                    O[db] = __builtin_amdgcn_mfma_f32_32x32x16_bf16(a, pack8(S[kbi], s), O[db], 0, 0, 0); }
        }
        bf16* op = o + mq * D + hq * 64 + 4 * h;
#pragma unroll
        for (int db = 0; db < 2; ++db)
#pragma unroll
            for (int g = 0; g < 4; ++g) { unsigned long long v = (unsigned long long)cvtpk_s(O[db][4 * g] * inv, O[db][4 * g + 1] * inv) | ((unsigned long long)cvtpk_s(O[db][4 * g + 2] * inv, O[db][4 * g + 3] * inv) << 32);
                *(GAS unsigned long long*)(op + 32 * db + 8 * g) = v; }
    }
}
__device__ __forceinline__ void swa_attn_phase(Frame& F, const bf16* qkv, const float* sinks, const float* rope, bf16* o) {
#pragma unroll 1
    for (int u = F.vcu; u < 512; u += F.G) swa_unit(F, qkv, sinks, rope, o, u >> 6, (u >> 4) & 3, u & 15);
    __syncthreads();
}

constexpr int GA_STR = 272, GB_STR = 320, GM_STR = 528, GX_B0 = 128 * GA_STR;
constexpr int GX_VS = GX_B0 + 128 * GM_STR;
static_assert(GX_VS + 512 <= RING_BYTES, "gmlp LDS");
__device__ __forceinline__ void gmlp_spatial_mfma(Frame& F, const bf16* z, const float* partv, const float* vg, const float* wsp, const float* bsp, bf16* y) {
    LAS unsigned char* L = F.lds + RING_OFF;
    const int lane = F.lane, wv = F.wave, c = lane & 31, h = lane >> 5;
    const int g = F.vcu & 15;
    __syncthreads();
    for (int e = F.tid; e < 2048; e += 512) { const int t = e >> 4, ch = e & 15; const float* src = wsp + (size_t)g * 16384 + t * 128 + 8 * ch;
        const f32x4 a = *(const GAS f32x4*)src, bq = *(const GAS f32x4*)(src + 4); float f[8] = {a.x, a.y, a.z, a.w, bq.x, bq.y, bq.z, bq.w};
#pragma unroll
        for (int k = 0; k < 8; ++k) f[k] = (8 * ch + k <= t) ? f[k] : 0.f;
        *(LAS v4u*)(L + t * GA_STR + ch * 16) = (v4u){pk2(f[0], f[1]), pk2(f[2], f[3]), pk2(f[4], f[5]), pk2(f[6], f[7])}; }
    const int tb = wv >> 1, wb0 = 2 * (wv & 1);
    const int g16 = (lane >> 4) & 1, i16 = lane & 15, tq = i16 >> 2, tp = i16 & 3;
    const LAS unsigned char* Ab = L + (32 * tb + c) * GA_STR + 16 * h;
    const LAS unsigned char* Bb = L + GX_B0 + (8 * h + tq) * GB_STR + (32 * wb0 + 16 * g16 + 4 * tp) * 2;
    const float vg0 = vg[g * 128 + 32 * wb0 + c], vg1 = vg[g * 128 + 32 * wb0 + 32 + c];
    f32x4 bias[4];
#pragma unroll
    for (int q = 0; q < 4; ++q) bias[q] = *(const GAS f32x4*)(bsp + g * 128 + 32 * tb + 8 * q + 4 * h);
    for (int cidx = F.vcu >> 4; cidx < 128; cidx += (F.G >> 4)) {
        const int r0 = cidx * 128;
        if (F.tid < 128) { const GAS f32x4* p = (const GAS f32x4*)(partv + (size_t)(r0 + F.tid) * 32); float sq = 0.f;
#pragma unroll
            for (int q = 0; q < 8; ++q) { const f32x4 v = p[q]; sq += (v.x + v.y) + (v.z + v.w); }
            *(LAS float*)(L + GX_VS + F.tid * 4) = 1.f / sqrtf(sq * (1.f / 2048.f) + EPS); }
        __syncthreads();
        for (int e = F.tid; e < 2048; e += 512) { const int s = e >> 4, ch = e & 15; float f[8]; unpack8(*(const GAS v4u*)(z + (size_t)(r0 + s) * GM_N + 2048 + g * 128 + 8 * ch), f);
            const float rs = *(const LAS float*)(L + GX_VS + s * 4);
            *(LAS v4u*)(L + GX_B0 + s * GB_STR + ch * 16) = (v4u){pk2(f[0] * rs, f[1] * rs), pk2(f[2] * rs, f[3] * rs), pk2(f[4] * rs, f[5] * rs), pk2(f[6] * rs, f[7] * rs)}; }
        __syncthreads();
        f32x16 acc0, acc1;
#pragma unroll
        for (int r = 0; r < 16; ++r) { acc0[r] = 0.f; acc1[r] = 0.f; }
#pragma unroll
        for (int ks = 0; ks < 8; ++ks) {
            if (ks <= 2 * tb + 1) {
                const bf16x8 a = *(const LAS bf16x8*)(Ab + 32 * ks);
                const s16x4 l0 = vtr(Bb + 16 * ks * GB_STR), h0 = vtr(Bb + (16 * ks + 4) * GB_STR), l1 = vtr(Bb + 16 * ks * GB_STR + 64), h1 = vtr(Bb + (16 * ks + 4) * GB_STR + 64);
                acc0 = __builtin_amdgcn_mfma_f32_32x32x16_bf16(a, (bf16x8){l0[0], l0[1], l0[2], l0[3], h0[0], h0[1], h0[2], h0[3]}, acc0, 0, 0, 0);
                acc1 = __builtin_amdgcn_mfma_f32_32x32x16_bf16(a, (bf16x8){l1[0], l1[1], l1[2], l1[3], h1[0], h1[1], h1[2], h1[3]}, acc1, 0, 0, 0);
            }
        }
        __syncthreads();
#pragma unroll
        for (int r = 0; r < 16; ++r) { const int t = 32 * tb + (r & 3) + 8 * (r >> 2) + 4 * h; const float bb = bias[r >> 2][r & 3];
            *(LAS float*)(L + GX_B0 + t * GM_STR + (32 * wb0 + c) * 4) = acc0[r] * vg0 + bb;
            *(LAS float*)(L + GX_B0 + t * GM_STR + (32 * wb0 + 32 + c) * 4) = acc1[r] * vg1 + bb; }
        __syncthreads();
        for (int e = F.tid; e < 2048; e += 512) { const int t = e >> 4, ch = e & 15; const size_t row = (size_t)(r0 + t);
            const f32x4 m0 = *(const LAS f32x4*)(L + GX_B0 + t * GM_STR + ch * 32), m1 = *(const LAS f32x4*)(L + GX_B0 + t * GM_STR + ch * 32 + 16);
            float uf[8]; unpack8(*(const GAS v4u*)(z + row * GM_N + g * 128 + 8 * ch), uf);
            *(GAS v4u*)(y + row * D + g * 128 + 8 * ch) = (v4u){pk2(uf[0] * m0.x, uf[1] * m0.y), pk2(uf[2] * m0.z, uf[3] * m0.w), pk2(uf[4] * m1.x, uf[5] * m1.y), pk2(uf[6] * m1.z, uf[7] * m1.w)}; }
        __syncthreads();
    }
}

__global__ void __launch_bounds__(NWAVES * 64, 2) mk_fwd(Args args) {
    extern __shared__ __attribute__((aligned(16))) unsigned char lds[];
    Frame F;
    F.lds = (LAS unsigned char*)lds;
    F.MISC = (volatile LAS unsigned*)(F.lds + MISC_OFF);
    F.tid = threadIdx.x; F.lane = F.tid & 63; F.wave = __builtin_amdgcn_readfirstlane(F.tid >> 6);
    F.G = gridDim.x; { const int bx = blockIdx.x; F.vcu = (F.G % 8 == 0) ? (bx % 8) * (F.G / 8) + bx / 8 : bx; }
    unsigned char* ws = args.ws;
    F.ctl = (gu32*)(ws + WS_CTL);
    for (int u = F.tid; u < (LDS_BYTES - LDSCTL_OFF) / 4; u += NWAVES * 64) ((LAS unsigned*)(F.lds + LDSCTL_OFF))[u] = 0u;
    __syncthreads();
    const int lo = args.ph_lo, hi = args.ph_hi;
    XcdBarrier bar; bar.bar = (unsigned*)(F.ctl + CW_BAR); bar.x = 0; bar.st = nullptr;
    if (hi - lo > 1) bar = xcd_barrier_post((unsigned*)(F.ctl + CW_BAR), F.MISC + 8);
    int ph = 0;
#define PH_BEGIN if (lo <= ph && ph < hi) { asm volatile("" : "+v"(F.tid), "+v"(F.lane), "+s"(F.wave), "+s"(F.vcu));
#define PH_END   if (ph + 1 < hi) xcd_barrier(bar); } ++ph;

    float* const h = args.out;
    bf16* const HB = (bf16*)(ws + WS_XN); bf16* const BIG = (bf16*)(ws + WS_BIG); bf16* const HID = (bf16*)(ws + WS_HID);
    float* const DEC = (float*)(ws + WS_SMALL + 1 * MiB); const float* const ROPE = (const float*)(ws + WS_SMALL + 2 * MiB);
    float* const PART = (float*)(ws + WS_SMALL + 3 * MiB); float* const PARTV = (float*)(ws + WS_SMALL + 5 * MiB); const bf16* const WFT = (const bf16*)(ws + WS_SMALL + 7 * MiB);
    const LAS float* const RS = (const LAS float*)(F.lds + RS_OFF);

    PH_BEGIN p0_prologue(F, args); PH_END

    for (int sl = 0; sl < 8; ++sl) {
        PH_BEGIN { panel_rstd(F, PART);
                   pg8::Gemm g{HB, (const bf16*)(ws + WS_W + sl * WS_FFN_STRIDE), M, 2 * FF, D}; pg8::StaticOrder S; S.init(M, 2 * FF, F.G, (int)blockIdx.x);
                   pg8::EpiSwiGLU E{HID, FF, RS};
                   pg8::gemm_phase<pg8::EpiSwiGLU, pg8::StaticOrder, true, true>(F.lds + RING_OFF, g, S, E); } PH_END
        PH_BEGIN { pg8::Gemm g{HID, (const bf16*)(ws + WS_W + sl * WS_FFN_STRIDE + WS_WO_OFF), M, D, FF}; pg8::StaticOrder S; S.init(M, D, F.G, (int)blockIdx.x, 4);
                   pg8::EpiResid E{HB, PART, D, 0.5f};
                   pg8::gemm_phase<pg8::EpiResid, pg8::StaticOrder, true, true>(F.lds + RING_OFF, g, S, E); } PH_END
        if (sl & 1) continue;
        const int L = sl >> 1;
        const bf16* win_t = (const bf16*)(ws + WS_MW + mw_win_off(L)); const bf16* wout_t = (const bf16*)(ws + WS_MW + mw_wout_off(L));
        if (L == 0 || L == 3) {
            PH_BEGIN { panel_rstd(F, PART);
                       pg8::Gemm g{HB, win_t, M, GM_N, D}; pg8::StaticOrder S; S.init(M, GM_N, F.G, (int)blockIdx.x);
                       pg8::EpiAct<1> E{BIG, GM_N, RS, PARTV, 8};
                       pg8::gemm_phase<pg8::EpiAct<1>, pg8::StaticOrder, true, true>(F.lds + RING_OFF, g, S, E); } PH_END
            PH_BEGIN gmlp_spatial_mfma(F, BIG, PARTV, args.mix_p0[L], args.mix_p1[L], args.mix_p2[L], HID); PH_END
        } else if (L == 1) {
            PH_BEGIN { panel_rstd(F, PART);
                       pg8::Gemm g{HB, win_t, M, SWA_N, D}; pg8::StaticOrder S; S.init(M, SWA_N, F.G, (int)blockIdx.x);
                       pg8::EpiAct<0> E{BIG, SWA_N, RS, nullptr, 0};
                       pg8::gemm_phase<pg8::EpiAct<0>, pg8::StaticOrder, true, true>(F.lds + RING_OFF, g, S, E); } PH_END
            PH_BEGIN swa_attn_phase(F, BIG, args.mix_p0[L], ROPE, HID); PH_END
        } else {
            PH_BEGIN { panel_rstd(F, PART); fox_fl(F, HB, WFT, args.mix_p0[L], DEC);
                       pg8::Gemm g{HB, win_t, M, FOX_N, D}; pg8::StaticOrder S; S.init(M, FOX_N, F.G, (int)blockIdx.x);
                       pg8::EpiAct<0> E{BIG, FOX_N, RS, nullptr, 0};
                       pg8::gemm_phase<pg8::EpiAct<0>, pg8::StaticOrder, true, true>(F.lds + RING_OFF, g, S, E); } PH_END
            PH_BEGIN fox_attn_phase(F, BIG, DEC, HID); PH_END
        }
        PH_BEGIN { pg8::Gemm g{HID, wout_t, M, D, D}; pg8::StaticOrder S; S.init(M, D, F.G, (int)blockIdx.x, 4);
                   pg8::EpiResid E{HB, PART, D, 1.0f};
                   pg8::gemm_phase<pg8::EpiResid, pg8::StaticOrder, true, true>(F.lds + RING_OFF, g, S, E); } PH_END
    }
    PH_BEGIN final_norm_phase(F, HB, h, args.final_norm); PH_END
#undef PH_BEGIN
#undef PH_END
}
constexpr int NPH = 1 + 8 * 2 + (3 + 3 + 3 + 3) + 1;

extern "C" void kernel_launch(void* const* d_in, const int* in_sizes, int n_in, void* d_out, int out_size, void* d_ws, size_t ws_size, hipStream_t stream) {
    static int grid = 0;
    if (grid == 0) {
        if (n_in != 46 || in_sizes[0] != M * D || out_size != M * D || ws_size < WS_END) { fprintf(stderr, "kernel_launch: unexpected shapes: n_in %d in0 %d out %d ws %zu (need %zu)\n", n_in, n_in > 0 ? in_sizes[0] : -1, out_size, ws_size, (size_t)WS_END); grid = -1; return; }
        int dev = 0, cus = 0;
        if (hipGetDevice(&dev) != hipSuccess || hipDeviceGetAttribute(&cus, hipDeviceAttributeMultiprocessorCount, dev) != hipSuccess) { grid = -1; return; }
        if (hipFuncSetAttribute((const void*)mk_fwd, hipFuncAttributeMaxDynamicSharedMemorySize, LDS_BYTES) != hipSuccess) { fprintf(stderr, "kernel_launch: hipFuncSetAttribute failed\n"); grid = -1; return; }
        (void)hipGetLastError();
        grid = cus;
        if (grid != 256) { fprintf(stderr, "kernel_launch: built for 256 CUs (the row-panel ownership of the fused norms), found %d\n", cus); grid = -1; return; }
    }
    if (grid < 0) return;
    if (hipMemsetAsync((char*)d_ws + WS_CTL, 0, CTL_ZERO_BYTES, stream) != hipSuccess) return;
    Args a{};
    a.x = (const float*)d_in[0];
    const int base[4] = {1, 13, 23, 33};
    for (int L = 0; L < 4; ++L) {
        const int b = base[L]; const bool gm = (L == 0 || L == 3);
        a.ffn_norm[2 * L] = (const float*)d_in[b]; a.ffn_wi[2 * L] = (const float*)d_in[b + 1]; a.ffn_wo[2 * L] = (const float*)d_in[b + 2];
        a.mix_norm[L] = (const float*)d_in[b + 3]; a.mix_win[L] = (const float*)d_in[b + 4];
        a.mix_p0[L] = (const float*)d_in[b + 5];
        int nx = b + 6;
        if (gm) { a.mix_p1[L] = (const float*)d_in[b + 6]; a.mix_p2[L] = (const float*)d_in[b + 7]; nx = b + 8; }
        a.mix_wout[L] = (const float*)d_in[nx];
        a.ffn_norm[2 * L + 1] = (const float*)d_in[nx + 1]; a.ffn_wi[2 * L + 1] = (const float*)d_in[nx + 2]; a.ffn_wo[2 * L + 1] = (const float*)d_in[nx + 3];
    }
    a.final_norm = (const float*)d_in[45];
    a.out = (float*)d_out; a.ws = (unsigned char*)d_ws;
#if MK_N_LAUNCHES == 1
    a.ph_lo = 0; a.ph_hi = NPH;
    hipLaunchKernelGGL(mk_fwd, dim3(grid), dim3(NWAVES * 64), LDS_BYTES, stream, a);
#else
    for (int p = 0; p < NPH; ++p) { a.ph_lo = p; a.ph_hi = p + 1; hipLaunchKernelGGL(mk_fwd, dim3(grid), dim3(NWAVES * 64), LDS_BYTES, stream, a); }
#endif
}
```
